# Optimizing an MI355X kernel written in HIP

```python
import jax, jax.numpy as jnp
from jax import lax
import numpy as np

D_MODEL = 1024
BATCH = 2
SEQ = 16384
DEPTH = 2

GRID_W = 64
ROPE_THETA = 10000.0

ATTN_HEADS = 8
ATTN_KV_HEADS = 2
ATTN_HEAD_DIM = 64
ATTN_WIDTH = ATTN_HEADS * ATTN_HEAD_DIM
KV_WIDTH = ATTN_KV_HEADS * ATTN_HEAD_DIM
Q_BLOCK = 128

CONV_CH = D_MODEL - ATTN_WIDTH
CONV_WIDTH = 31
CONV_PAD = CONV_WIDTH // 2
L0_IN = ATTN_WIDTH + 2 * KV_WIDTH + 2 * CONV_CH

RET_HEADS = 4
RET_KEY_DIM = D_MODEL // RET_HEADS
RET_VAL_DIM = 2 * RET_KEY_DIM
RET_QK_WIDTH = RET_HEADS * RET_KEY_DIM
RET_V_WIDTH = RET_HEADS * RET_VAL_DIM
L1_IN = 2 * RET_QK_WIDTH + 2 * RET_V_WIDTH
RET_CHUNK = 128

FFN_HIDDEN = -(-8 * D_MODEL // (3 * 256)) * 256

DEEPNORM_ALPHA = (2 * DEPTH) ** 0.25
DEEPNORM_BETA = (8 * DEPTH) ** -0.25
LN_EPS = 1e-5
RMS_EPS = 1e-6

kernel_name = 'hybrid_attn_conv_retention_encoder'


def layer_norm(x, g, b, eps=LN_EPS):
    xf = x.astype(jnp.float32)
    mu = jnp.mean(xf, axis=-1, keepdims=True)
    var = jnp.mean(jnp.square(xf - mu), axis=-1, keepdims=True)
    y = (xf - mu) * lax.rsqrt(var + eps)
    return (y * g.astype(jnp.float32) + b.astype(jnp.float32)).astype(x.dtype)


def rms_norm(x, g, eps=RMS_EPS):
    xf = x.astype(jnp.float32)
    y = xf * lax.rsqrt(jnp.mean(jnp.square(xf), axis=-1, keepdims=True) + eps)
    return (y * g.astype(jnp.float32)).astype(x.dtype)


def axial_rope(seq_len, head_dim):
    rows = seq_len // GRID_W
    row = jnp.broadcast_to(jnp.arange(rows, dtype=jnp.float32)[:, None], (rows, GRID_W)).reshape(seq_len)
    col = jnp.broadcast_to(jnp.arange(GRID_W, dtype=jnp.float32)[None, :], (rows, GRID_W)).reshape(seq_len)
    axis_dim = head_dim // 2
    inv_freq = ROPE_THETA ** (-jnp.arange(0, axis_dim, 2, dtype=jnp.float32) / axis_dim)
    ang = jnp.concatenate([row[:, None] * inv_freq, col[:, None] * inv_freq], axis=-1)
    return jnp.cos(ang), jnp.sin(ang)


def apply_rope(x, cos, sin):
    half = x.shape[-1] // 2
    xf = x.astype(jnp.float32)
    x1, x2 = xf[..., :half], xf[..., half:]
    c = cos[None, :, None, :]
    s = sin[None, :, None, :]
    return jnp.concatenate([x1 * c - x2 * s, x1 * s + x2 * c], axis=-1).astype(x.dtype)


def block_attention(q, k, v):
    B, S = q.shape[0], q.shape[1]
    G = ATTN_HEADS // ATTN_KV_HEADS
    nblk = S // Q_BLOCK
    qb = q.reshape(B, nblk, Q_BLOCK, ATTN_KV_HEADS, G, ATTN_HEAD_DIM).transpose(1, 0, 2, 3, 4, 5)
    scale = ATTN_HEAD_DIM ** -0.5

    def one_block(q_blk):
        s = jnp.einsum('bqkgd,bskd->bkgqs', q_blk, k).astype(jnp.float32) * scale
        p = jax.nn.softmax(s, axis=-1).astype(v.dtype)
        return jnp.einsum('bkgqs,bskd->bqkgd', p, v)

    o = lax.map(one_block, qb)
    return o.transpose(1, 0, 2, 3, 4, 5).reshape(B, S, ATTN_WIDTH)


def conformer_conv(u, dw_w, dw_b, norm_g, norm_b):
    a, gate = jnp.split(u, 2, axis=-1)
    z = a * jax.nn.sigmoid(gate)
    z = lax.conv_general_dilated(
        z, dw_w[:, None, :].astype(z.dtype), window_strides=(1,),
        padding=[(CONV_PAD, CONV_PAD)], dimension_numbers=('NWC', 'WIO', 'NWC'),
        feature_group_count=CONV_CH) + dw_b
    z = layer_norm(z, norm_g, norm_b)
    return jax.nn.silu(z)


def attn_conv_mixer(x, w_in, q_norm_g, k_norm_g, dw_w, dw_b, conv_norm_g, conv_norm_b, w_out, cos, sin):
    B, S, _ = x.shape
    proj = x @ w_in
    q, k, v, u = jnp.split(proj, [ATTN_WIDTH, ATTN_WIDTH + KV_WIDTH, ATTN_WIDTH + 2 * KV_WIDTH], axis=-1)
    q = q.reshape(B, S, ATTN_HEADS, ATTN_HEAD_DIM)
    k = k.reshape(B, S, ATTN_KV_HEADS, ATTN_HEAD_DIM)
    v = v.reshape(B, S, ATTN_KV_HEADS, ATTN_HEAD_DIM)
    q = apply_rope(rms_norm(q, q_norm_g), cos, sin)
    k = apply_rope(rms_norm(k, k_norm_g), cos, sin)
    attn = block_attention(q, k, v)
    conv = conformer_conv(u, dw_w, dw_b, conv_norm_g, conv_norm_b)
    return jnp.concatenate([attn, conv], axis=-1) @ w_out


def retention_scan(q, k, v, log_gamma, strict):
    B, H, S, dk = q.shape
    dv = v.shape[-1]
    C = RET_CHUNK
    nC = S // C
    lg = log_gamma.astype(jnp.float32)
    pos = jnp.arange(C, dtype=jnp.float32)
    diff = pos[:, None] - pos[None, :]
    mask = (diff > 0) if strict else (diff >= 0)
    intra = jnp.where(mask[None], jnp.exp(lg[:, None, None] * jnp.where(mask, diff, 0.0)[None]), 0.0)
    q_decay = jnp.exp(lg[:, None] * (pos + 1.0)[None])
    k_decay = jnp.exp(lg[:, None] * (C - 1.0 - pos)[None])
    chunk_decay = jnp.exp(lg * C)

    def to_chunks(t):
        return t.reshape(B, H, nC, C, t.shape[-1]).transpose(2, 0, 1, 3, 4)

    def step(state, inp):
        qi, ki, vi = inp
        scores = jnp.einsum('bhqd,bhkd->bhqk', qi, ki) * intra[None]
        o = jnp.einsum('bhqk,bhkv->bhqv', scores, vi) + jnp.einsum(
            'bhqd,bhdv->bhqv', qi * q_decay[None, :, :, None], state)
        state = state * chunk_decay[None, :, None, None] + jnp.einsum(
            'bhkd,bhkv->bhdv', ki * k_decay[None, :, :, None], vi)
        return state, o

    state0 = jnp.zeros((B, H, dk, dv), jnp.float32)
    _, o = lax.scan(step, state0, (to_chunks(q), to_chunks(k), to_chunks(v)))
    return o.transpose(1, 2, 0, 3, 4).reshape(B, H, S, dv)


def retention_mixer(x, w_in, log_decay_fwd, log_decay_bwd, ret_norm_g, w_out, cos, sin):
    B, S, _ = x.shape
    proj = x @ w_in
    q, k, v, g = jnp.split(proj, [RET_QK_WIDTH, 2 * RET_QK_WIDTH, 2 * RET_QK_WIDTH + RET_V_WIDTH], axis=-1)
    q = apply_rope(q.reshape(B, S, RET_HEADS, RET_KEY_DIM), cos, sin)
    k = apply_rope(k.reshape(B, S, RET_HEADS, RET_KEY_DIM), cos, sin)
    v = v.reshape(B, S, RET_HEADS, RET_VAL_DIM)
    qh = q.transpose(0, 2, 1, 3).astype(jnp.float32)
    kh = k.transpose(0, 2, 1, 3).astype(jnp.float32) * (RET_KEY_DIM ** -0.5)
    vh = v.transpose(0, 2, 1, 3).astype(jnp.float32)
    o_fwd = retention_scan(qh, kh, vh, log_decay_fwd, strict=False)
    o_bwd = jnp.flip(retention_scan(jnp.flip(qh, 2), jnp.flip(kh, 2), jnp.flip(vh, 2),
                                    log_decay_bwd, strict=True), 2)
    y = (o_fwd + o_bwd).transpose(0, 2, 1, 3)
    mu = jnp.mean(y, axis=-1, keepdims=True)
    var = jnp.mean(jnp.square(y - mu), axis=-1, keepdims=True)
    y = ((y - mu) * lax.rsqrt(var + LN_EPS)).reshape(B, S, RET_V_WIDTH)
    y = (y * ret_norm_g.astype(jnp.float32)).astype(x.dtype)
    return (jax.nn.silu(g) * y) @ w_out


def swiglu(x, w_gate, w_up, w_down):
    return (jax.nn.silu(x @ w_gate) * (x @ w_up)) @ w_down


def setup_inputs(seed: int = 0) -> dict:
    key = jax.random.key(seed)
    ks = iter(jax.random.split(key, 40))

    def normal(shape, scale):
        return jax.random.normal(next(ks), shape, jnp.float32) * scale

    def gain(n):
        return 1.0 + normal((n,), 0.02)

    base_decay = jnp.asarray(np.log(1.0 - 2.0 ** (-5.0 - np.arange(RET_HEADS))), jnp.float32)
    d = D_MODEL
    inp = {}
    inp['x'] = normal((BATCH, SEQ, d), 1.0)
    inp['l0_w_in'] = normal((d, L0_IN), d ** -0.5)
    inp['l0_q_norm_g'] = gain(ATTN_HEAD_DIM)
    inp['l0_k_norm_g'] = gain(ATTN_HEAD_DIM)
    inp['l0_dw_w'] = normal((CONV_WIDTH, CONV_CH), CONV_WIDTH ** -0.5)
    inp['l0_dw_b'] = normal((CONV_CH,), 0.02)
    inp['l0_conv_norm_g'] = gain(CONV_CH)
    inp['l0_conv_norm_b'] = normal((CONV_CH,), 0.02)
    inp['l0_w_out'] = normal((ATTN_WIDTH + CONV_CH, d), (ATTN_WIDTH + CONV_CH) ** -0.5 * DEEPNORM_BETA)
    inp['l0_ln_mix_g'] = gain(d)
    inp['l0_ln_mix_b'] = normal((d,), 0.02)
    inp['l0_ffn_w_gate'] = normal((d, FFN_HIDDEN), d ** -0.5)
    inp['l0_ffn_w_up'] = normal((d, FFN_HIDDEN), d ** -0.5)
    inp['l0_ffn_w_down'] = normal((FFN_HIDDEN, d), FFN_HIDDEN ** -0.5 * DEEPNORM_BETA)
    inp['l0_ln_ffn_g'] = gain(d)
    inp['l0_ln_ffn_b'] = normal((d,), 0.02)
    inp['l1_w_in'] = normal((d, L1_IN), d ** -0.5)
    inp['l1_log_decay_fwd'] = base_decay * (1.0 + normal((RET_HEADS,), 0.05))
    inp['l1_log_decay_bwd'] = base_decay * (1.0 + normal((RET_HEADS,), 0.05))
    inp['l1_ret_norm_g'] = gain(RET_V_WIDTH)
    inp['l1_w_out'] = normal((RET_V_WIDTH, d), RET_V_WIDTH ** -0.5 * DEEPNORM_BETA)
    inp['l1_ln_mix_g'] = gain(d)
    inp['l1_ln_mix_b'] = normal((d,), 0.02)
    inp['l1_ffn_w_gate'] = normal((d, FFN_HIDDEN), d ** -0.5)
    inp['l1_ffn_w_up'] = normal((d, FFN_HIDDEN), d ** -0.5)
    inp['l1_ffn_w_down'] = normal((FFN_HIDDEN, d), FFN_HIDDEN ** -0.5 * DEEPNORM_BETA)
    inp['l1_ln_ffn_g'] = gain(d)
    inp['l1_ln_ffn_b'] = normal((d,), 0.02)
    return inp


def reference(x, l0_w_in, l0_q_norm_g, l0_k_norm_g, l0_dw_w, l0_dw_b, l0_conv_norm_g, l0_conv_norm_b,
              l0_w_out, l0_ln_mix_g, l0_ln_mix_b, l0_ffn_w_gate, l0_ffn_w_up, l0_ffn_w_down,
              l0_ln_ffn_g, l0_ln_ffn_b, l1_w_in, l1_log_decay_fwd, l1_log_decay_bwd, l1_ret_norm_g,
              l1_w_out, l1_ln_mix_g, l1_ln_mix_b, l1_ffn_w_gate, l1_ffn_w_up, l1_ffn_w_down,
              l1_ln_ffn_g, l1_ln_ffn_b):
    S = x.shape[1]
    cos_a, sin_a = axial_rope(S, ATTN_HEAD_DIM)
    cos_r, sin_r = axial_rope(S, RET_KEY_DIM)

    mixer_params = (
        (l0_w_in, l0_q_norm_g, l0_k_norm_g, l0_dw_w, l0_dw_b, l0_conv_norm_g, l0_conv_norm_b, l0_w_out),
        (l1_w_in, l1_log_decay_fwd, l1_log_decay_bwd, l1_ret_norm_g, l1_w_out),
    )
    mix_norms = ((l0_ln_mix_g, l0_ln_mix_b), (l1_ln_mix_g, l1_ln_mix_b))
    ffn_params = ((l0_ffn_w_gate, l0_ffn_w_up, l0_ffn_w_down), (l1_ffn_w_gate, l1_ffn_w_up, l1_ffn_w_down))
    ffn_norms = ((l0_ln_ffn_g, l0_ln_ffn_b), (l1_ln_ffn_g, l1_ln_ffn_b))

    for layer in range(DEPTH):
        if layer % 2 == 0:
            m = attn_conv_mixer(x, *mixer_params[layer], cos_a, sin_a)
        else:
            m = retention_mixer(x, *mixer_params[layer], cos_r, sin_r)
        x = layer_norm(DEEPNORM_ALPHA * x + m, *mix_norms[layer])
        x = layer_norm(DEEPNORM_ALPHA * x + swiglu(x, *ffn_params[layer]), *ffn_norms[layer])
    return x
```

```cpp
#include <hip/hip_runtime.h>
#include <hip/hip_cooperative_groups.h>
#include <hip/hip_bf16.h>
#include <cstdio>
#include <cstdint>
#include <cmath>
namespace cg = cooperative_groups;

namespace pg8 {
#define PG8_LAS __attribute__((address_space(3)))
typedef unsigned short bf16_t;
typedef short bf16x8 __attribute__((ext_vector_type(8)));
typedef float f32x4 __attribute__((ext_vector_type(4)));
typedef unsigned u32x4 __attribute__((ext_vector_type(4)));
constexpr int BM = 256, BK = 64, HALF = 128, HTB = HALF * BK * 2  , STAGE_BYTES = 8 * HTB, NXCD = 8, WGM = 8;

__host__ __device__ __forceinline__ int lds_byte(int r, int c) { const int st = (r >> 4) * 2 + (c >> 5), rr = r & 15, cc = c & 31, ob = rr * 64 + cc * 2; return st * 1024 + (ob ^ (((ob >> 9) & 1) << 5)); }
__host__ __device__ __forceinline__ void stage_rc(int b, int& R, int& C) { const int st = b / 1024, sb = b % 1024, swz = sb ^ (((sb >> 9) & 1) << 5); R = (st >> 1) * 16 + swz / 64; C = (st & 1) * 32 + (swz % 64) / 2; }
__host__ __device__ __forceinline__ int perm32(int rho) { const int n = rho >> 4, i = rho & 15; return 8 * (i >> 2) + 4 * n + (i & 3); }

struct Unit { int pm, pn; };
struct Gemm { const bf16_t* A; const bf16_t* Bt; int M, N, K; };

struct StaticOrder {
    int nM, nN, nwg, G, c;
    __host__ __device__ void init(int M, int N, int G_, int c_) { nM = M / BM; nN = N / BM; nwg = nM * nN; G = G_; c = c_; }
    __host__ __device__ bool next(int i, Unit& u) const {
        const long L = (long)i * G + c; if (L >= nwg) return false;
        int wgid = (int)L; { const int q = nwg / NXCD, r = nwg % NXCD, xcd = wgid % NXCD, off = wgid / NXCD; wgid = (xcd < r ? xcd * (q + 1) : r * (q + 1) + (xcd - r) * q) + off; }
        const int nig = WGM * nN, gid = wgid / nig, fm = gid * WGM, gsz = (nM - fm) < WGM ? (nM - fm) : WGM;
        u.pm = fm + ((wgid % nig) % gsz); u.pn = (wgid % nig) / gsz; return true;
    }
    __device__ __forceinline__ void a_ready(const Unit&) const {}
    __device__ __forceinline__ void done(const Unit&) const {}
};

__device__ __forceinline__ unsigned cvt_pk_bf16(float lo, float hi) { unsigned r; asm volatile("v_cvt_pk_bf16_f32 %0, %1, %2" : "=v"(r) : "v"(lo), "v"(hi)); return r; }
typedef float f32x2 __attribute__((ext_vector_type(2)));
__device__ __forceinline__ float silu_f(float v) { return v * __builtin_amdgcn_rcpf(1.0f + __builtin_amdgcn_exp2f(v * -1.4426950408889634f)); }
__device__ __forceinline__ float bf_lo(unsigned w) { return __uint_as_float(w << 16); }
__device__ __forceinline__ float bf_hi(unsigned w) { return __uint_as_float(w & 0xffff0000u); }
struct EpiBf16 {
    static constexpr bool PERM = true, AFTER_DRAIN = false;
    bf16_t* O; int ldc;
    __device__ __forceinline__ void operator()(const f32x4 (&acc)[2][2][4][2], const Unit& u, int wr, int wc, int fr, int fq) const {
        const int row0 = u.pm * BM + wr * 64 + fr; const int col0 = u.pn * BM + wc * 32 + 8 * fq;
#pragma unroll
        for (int ai = 0; ai < 2; ++ai)
#pragma unroll
            for (int m = 0; m < 4; ++m) { bf16_t* rowp = O + (size_t)(row0 + ai * HALF + m * 16) * ldc + col0;
#pragma unroll
                for (int bj = 0; bj < 2; ++bj) { const f32x4 v0 = acc[ai][bj][m][0], v1 = acc[ai][bj][m][1];
                    u32x4 w; w.x = cvt_pk_bf16(v0[0], v0[1]); w.y = cvt_pk_bf16(v0[2], v0[3]); w.z = cvt_pk_bf16(v1[0], v1[1]); w.w = cvt_pk_bf16(v1[2], v1[3]);
                    *(u32x4*)(rowp + bj * HALF) = w; } }
    }
};
struct EpiGateUp {
    static constexpr bool PERM = true, AFTER_DRAIN = false;
    bf16_t* O; int ldc;
    __device__ __forceinline__ void operator()(const f32x4 (&acc)[2][2][4][2], const Unit& u, int wr, int wc, int fr, int fq) const {
        const int row0 = u.pm * BM + wr * 64 + fr; const int col0 = u.pn * HALF + wc * 32 + 8 * fq;
#pragma unroll
        for (int ai = 0; ai < 2; ++ai)
#pragma unroll
            for (int m = 0; m < 4; ++m) { bf16_t* rowp = O + (size_t)(row0 + ai * HALF + m * 16) * ldc + col0;
                const f32x4 g0 = acc[ai][0][m][0], g1 = acc[ai][0][m][1], u0 = acc[ai][1][m][0], u1 = acc[ai][1][m][1];
                u32x4 w;
                w.x = cvt_pk_bf16(silu_f(g0[0]) * u0[0], silu_f(g0[1]) * u0[1]); w.y = cvt_pk_bf16(silu_f(g0[2]) * u0[2], silu_f(g0[3]) * u0[3]);
                w.z = cvt_pk_bf16(silu_f(g1[0]) * u1[0], silu_f(g1[1]) * u1[1]); w.w = cvt_pk_bf16(silu_f(g1[2]) * u1[2], silu_f(g1[3]) * u1[3]);
                *(u32x4*)rowp = w; }
    }
};
struct EpiResF32 {
    static constexpr bool PERM = false, AFTER_DRAIN = false;
    const float* res; float* out; int ldc; float alpha;
    __device__ __forceinline__ void operator()(const f32x4 (&acc)[2][2][4][2], const Unit& u, int wr, int wc, int fr, int fq) const {
        const int col0 = u.pn * BM + wc * 32 + 4 * fq;
#pragma unroll
        for (int ai = 0; ai < 2; ++ai)
#pragma unroll
            for (int m = 0; m < 4; ++m) { const size_t off = (size_t)(u.pm * BM + ai * HALF + wr * 64 + m * 16 + fr) * ldc + col0;
#pragma unroll
                for (int bj = 0; bj < 2; ++bj)
#pragma unroll
                    for (int n = 0; n < 2; ++n) { const f32x4 r4 = *(const f32x4*)(res + off + bj * HALF + n * 16);
                        *(f32x4*)(out + off + bj * HALF + n * 16) = r4 * alpha + acc[ai][bj][m][n]; } }
    }
};
struct EpiGateMul {
    static constexpr bool PERM = true, AFTER_DRAIN = false;
    bf16_t* O; int ldc;
    __device__ __forceinline__ void operator()(const f32x4 (&acc)[2][2][4][2], const Unit& u, int wr, int wc, int fr, int fq) const {
        const int row0 = u.pm * BM + wr * 64 + fr; const int col0 = u.pn * BM + wc * 32 + 8 * fq;
#pragma unroll
        for (int ai = 0; ai < 2; ++ai)
#pragma unroll
            for (int m = 0; m < 4; ++m) { bf16_t* rowp = O + (size_t)(row0 + ai * HALF + m * 16) * ldc + col0;
#pragma unroll
                for (int bj = 0; bj < 2; ++bj) { const f32x4 v0 = acc[ai][bj][m][0], v1 = acc[ai][bj][m][1];
                    const u32x4 y = *(const u32x4*)(rowp + bj * HALF); u32x4 w;
                    w.x = cvt_pk_bf16(silu_f(v0[0]) * bf_lo(y.x), silu_f(v0[1]) * bf_hi(y.x)); w.y = cvt_pk_bf16(silu_f(v0[2]) * bf_lo(y.y), silu_f(v0[3]) * bf_hi(y.y));
                    w.z = cvt_pk_bf16(silu_f(v1[0]) * bf_lo(y.z), silu_f(v1[1]) * bf_hi(y.z)); w.w = cvt_pk_bf16(silu_f(v1[2]) * bf_lo(y.w), silu_f(v1[3]) * bf_hi(y.w));
                    *(u32x4*)(rowp + bj * HALF) = w; } }
    }
};

struct EpiQKV1 {
    static constexpr bool PERM = true, AFTER_DRAIN = false;
    bf16_t* Qh; bf16_t* Kh; bf16_t* Vh; const float* tab;
    __device__ __forceinline__ void operator()(const f32x4 (&acc)[2][2][4][2], const Unit& u, int wr, int wc, int fr, int fq) const {
        constexpr int S_ = 16384;
        const int b = u.pm >> 6;
        if (u.pn < 8) {
            const int h = u.pn & 3; bf16_t* base = (u.pn < 4 ? Qh : Kh) + (size_t)(3 * b + h) * S_ * 256;
            const float sc = (u.pn < 4) ? 1.0f : 0.0625f;
            const int idx = wc * 32 + 8 * fq;
#pragma unroll
            for (int ai = 0; ai < 2; ++ai)
#pragma unroll
                for (int m = 0; m < 4; ++m) {
                    const int r = u.pm * BM + ai * HALF + wr * 64 + m * 16 + fr, s = r & (S_ - 1);
                    const int pos = (wc < 2) ? (s >> 6) : (s & 63);
                    const f32x4* tp = (const f32x4*)(tab + ((size_t)pos * 64 + (idx & 63)) * 2);
                    const f32x4 t0 = tp[0], t1 = tp[1], t2 = tp[2], t3 = tp[3];
                    const f32x4 a0 = acc[ai][0][m][0], a1 = acc[ai][0][m][1], b0 = acc[ai][1][m][0], b1 = acc[ai][1][m][1];
                    u32x4 w1, w2;
                    w1.x = cvt_pk_bf16((a0[0] * t0[0] - b0[0] * t0[1]) * sc, (a0[1] * t0[2] - b0[1] * t0[3]) * sc);
                    w1.y = cvt_pk_bf16((a0[2] * t1[0] - b0[2] * t1[1]) * sc, (a0[3] * t1[2] - b0[3] * t1[3]) * sc);
                    w1.z = cvt_pk_bf16((a1[0] * t2[0] - b1[0] * t2[1]) * sc, (a1[1] * t2[2] - b1[1] * t2[3]) * sc);
                    w1.w = cvt_pk_bf16((a1[2] * t3[0] - b1[2] * t3[1]) * sc, (a1[3] * t3[2] - b1[3] * t3[3]) * sc);
                    w2.x = cvt_pk_bf16((a0[0] * t0[1] + b0[0] * t0[0]) * sc, (a0[1] * t0[3] + b0[1] * t0[2]) * sc);
                    w2.y = cvt_pk_bf16((a0[2] * t1[1] + b0[2] * t1[0]) * sc, (a0[3] * t1[3] + b0[3] * t1[2]) * sc);
                    w2.z = cvt_pk_bf16((a1[0] * t2[1] + b1[0] * t2[0]) * sc, (a1[1] * t2[3] + b1[1] * t2[2]) * sc);
                    w2.w = cvt_pk_bf16((a1[2] * t3[1] + b1[2] * t3[0]) * sc, (a1[3] * t3[3] + b1[3] * t3[2]) * sc);
                    bf16_t* rowp = base + (size_t)r * 256 + idx;
                    *(u32x4*)rowp = w1; *(u32x4*)(rowp + 128) = w2;
                }
        } else {
            const int hv = (u.pn - 8) >> 1, hf = (u.pn - 8) & 1; bf16_t* base = Vh + (size_t)(3 * b + hv) * S_ * 512 + hf * 256 + wc * 32 + 8 * fq;
#pragma unroll
            for (int ai = 0; ai < 2; ++ai)
#pragma unroll
                for (int m = 0; m < 4; ++m) { bf16_t* rowp = base + (size_t)(u.pm * BM + ai * HALF + wr * 64 + m * 16 + fr) * 512;
#pragma unroll
                    for (int bj = 0; bj < 2; ++bj) { const f32x4 v0 = acc[ai][bj][m][0], v1 = acc[ai][bj][m][1];
                        u32x4 w; w.x = cvt_pk_bf16(v0[0], v0[1]); w.y = cvt_pk_bf16(v0[2], v0[3]); w.z = cvt_pk_bf16(v1[0], v1[1]); w.w = cvt_pk_bf16(v1[2], v1[3]);
                        *(u32x4*)(rowp + bj * HALF) = w; } }
        }
    }
};

template <class Epi, class Sched, bool ALIGN_EPI = false, bool SP2 = false>
__device__ __forceinline__ void gemm_phase(PG8_LAS unsigned char* lds, const Gemm g, const Sched& S, const Epi& E) {
    const int tid = threadIdx.x, wid = __builtin_amdgcn_readfirstlane(tid >> 6), lane = tid & 63, wr = wid >> 2, wc = wid & 3, fr = lane & 15, fq = lane >> 4;
    const int K = g.K, nt = K / BK;
    unsigned voffA[2], voffB[2];
#pragma unroll
    for (int i = 0; i < 2; ++i) { int R, C; stage_rc(tid * 16 + i * 8192, R, C); const int Rb = Epi::PERM ? ((R & ~31) + perm32(R & 31)) : R;
        voffA[i] = (unsigned)(R * K + C) * 2u; voffB[i] = (unsigned)(Rb * K + C) * 2u; }
    const size_t kstep = (size_t)(BK * 2);
    const size_t hstep = (size_t)HALF * K * 2;
    const size_t tstep = 2 * hstep;
    const unsigned ldsw = (unsigned)wid * 1024u;
    const int aoff = lds_byte(wr * 64 + fr, fq * 8), boff = lds_byte(wc * 32 + fr, fq * 8);
#define PG8_SA(b, h) (((b) * 2 + (h)) * HTB)
#define PG8_SB(b, h) ((4 + (b) * 2 + (h)) * HTB)
#define PG8_STAGE(bufoff, gbase, voff) do { _Pragma("unroll") for (int _i = 0; _i < 2; ++_i) \
        __builtin_amdgcn_global_load_lds((const unsigned*)((const char*)(gbase) + (voff)[_i]), (PG8_LAS unsigned*)(lds + (bufoff) + ldsw + _i * 8192), 16, 0, 0); } while (0)
#define PG8_LDA(dst, b, h) do { _Pragma("unroll") for (int m = 0; m < 4; ++m) _Pragma("unroll") for (int k = 0; k < 2; ++k) dst[m][k] = *(const PG8_LAS bf16x8*)(lds + PG8_SA(b, h) + aoff + m * 2048 + k * 1024); } while (0)
#define PG8_LDB(dst, b, h) do { _Pragma("unroll") for (int n = 0; n < 2; ++n) _Pragma("unroll") for (int k = 0; k < 2; ++k) dst[n][k] = *(const PG8_LAS bf16x8*)(lds + PG8_SB(b, h) + boff + n * 2048 + k * 1024); } while (0)
#define PG8_MMA(ai, bj, At, Bt) do { __builtin_amdgcn_s_setprio(1); _Pragma("unroll") for (int m = 0; m < 4; ++m) _Pragma("unroll") for (int n = 0; n < 2; ++n) _Pragma("unroll") for (int k = 0; k < 2; ++k) \
        acc[ai][bj][m][n] = __builtin_amdgcn_mfma_f32_16x16x32_bf16(Bt[n][k], At[m][k], acc[ai][bj][m][n], 0, 0, 0); __builtin_amdgcn_s_setprio(0); } while (0)
#define PG8_WAIT_V(n) asm volatile("s_waitcnt vmcnt(" #n ")" ::: "memory")
#define PG8_WAIT_L(n) asm volatile("s_waitcnt lgkmcnt(" #n ")" ::: "memory")
#define PG8_BAR __builtin_amdgcn_s_barrier()
#define PG8_SCHED __builtin_amdgcn_sched_barrier(0)
    Unit cur, nxt; int ui = 0;
    if (!S.next(0, cur)) return;
    f32x4 acc[2][2][4][2];
#pragma unroll
    for (int a = 0; a < 2; ++a)
#pragma unroll
        for (int b = 0; b < 2; ++b)
#pragma unroll
            for (int m = 0; m < 4; ++m)
#pragma unroll
                for (int n = 0; n < 2; ++n) acc[a][b][m][n] = (f32x4){0.f, 0.f, 0.f, 0.f};
    bf16x8 At[4][2], B0[2][2], B1[2][2];
    const char* cA = (const char*)g.A + (size_t)cur.pm * tstep; const char* cB = (const char*)g.Bt + (size_t)cur.pn * tstep;
    S.a_ready(cur);
    if constexpr (SP2) {
        PG8_STAGE(PG8_SB(0, 0), cB, voffB); PG8_STAGE(PG8_SB(0, 1), cB + hstep, voffB); PG8_STAGE(PG8_SA(0, 0), cA, voffA); PG8_STAGE(PG8_SA(0, 1), cA + hstep, voffA);
        if (wr == 1) PG8_BAR;
        PG8_WAIT_V(2); PG8_BAR;
        PG8_STAGE(PG8_SB(1, 0), cB + kstep, voffB); PG8_STAGE(PG8_SA(1, 0), cA + kstep, voffA); PG8_STAGE(PG8_SB(1, 1), cB + hstep + kstep, voffB);
        PG8_WAIT_V(6); PG8_BAR;
    } else {
        PG8_STAGE(PG8_SB(0, 0), cB, voffB); PG8_STAGE(PG8_SA(0, 0), cA, voffA); PG8_STAGE(PG8_SB(0, 1), cB + hstep, voffB); PG8_STAGE(PG8_SA(0, 1), cA + hstep, voffA);
        if (wr == 1) PG8_BAR;
        PG8_WAIT_V(4); PG8_BAR;
        PG8_STAGE(PG8_SB(1, 0), cB + kstep, voffB); PG8_STAGE(PG8_SA(1, 0), cA + kstep, voffA); PG8_STAGE(PG8_SB(1, 1), cB + hstep + kstep, voffB);
        PG8_WAIT_V(6); PG8_BAR;
    }
    for (;;) {
        const bool has_next = S.next(ui + 1, nxt);
        const char* nA = has_next ? (const char*)g.A + (size_t)nxt.pm * tstep : cA; const char* nB = has_next ? (const char*)g.Bt + (size_t)nxt.pn * tstep : cB;
        for (int t = 0; t < nt; t += 2) {
            const bool last = (t == nt - 2);
            const char* a1 = cA + (size_t)(t + 1) * kstep;
            const char* a2 = last ? nA : cA + (size_t)(t + 2) * kstep; const char* b2 = last ? nB : cB + (size_t)(t + 2) * kstep;
            const char* a3 = a2 + kstep; const char* b3 = b2 + kstep;
            if (last && has_next) S.a_ready(nxt);
            if constexpr (SP2) {
            PG8_LDB(B0, 0, 0); PG8_LDB(B1, 0, 1); PG8_SCHED; PG8_LDA(At, 0, 0); PG8_STAGE(PG8_SA(1, 1), a1 + hstep, voffA);
            PG8_WAIT_V(8); PG8_WAIT_L(0); PG8_BAR; PG8_MMA(0, 0, At, B0); PG8_MMA(0, 1, At, B1); PG8_BAR; PG8_SCHED;
            PG8_LDA(At, 0, 1); PG8_STAGE(PG8_SB(0, 0), b2, voffB); PG8_STAGE(PG8_SB(0, 1), b2 + hstep, voffB); PG8_STAGE(PG8_SA(0, 0), a2, voffA);
            PG8_WAIT_V(8); PG8_WAIT_L(0); PG8_BAR; PG8_MMA(1, 0, At, B0); PG8_MMA(1, 1, At, B1); PG8_BAR; PG8_SCHED;
            PG8_LDB(B0, 1, 0); PG8_LDB(B1, 1, 1); PG8_SCHED; PG8_LDA(At, 1, 0); PG8_STAGE(PG8_SA(0, 1), a2 + hstep, voffA);
            PG8_WAIT_V(8); PG8_WAIT_L(0); PG8_BAR; PG8_MMA(0, 0, At, B0); PG8_MMA(0, 1, At, B1); PG8_BAR; PG8_SCHED;
            PG8_LDA(At, 1, 1); PG8_STAGE(PG8_SB(1, 0), b3, voffB); PG8_STAGE(PG8_SB(1, 1), b3 + hstep, voffB); PG8_STAGE(PG8_SA(1, 0), a3, voffA);
            PG8_WAIT_V(8); PG8_WAIT_L(0); PG8_BAR; PG8_MMA(1, 0, At, B0); PG8_MMA(1, 1, At, B1); PG8_BAR; PG8_SCHED;
            } else {
            PG8_LDB(B0, 0, 0); PG8_SCHED; PG8_LDA(At, 0, 0); PG8_STAGE(PG8_SA(1, 1), a1 + hstep, voffA);
            PG8_WAIT_L(8); PG8_BAR; PG8_WAIT_L(0); PG8_MMA(0, 0, At, B0); PG8_BAR; PG8_SCHED;
            PG8_LDB(B1, 0, 1); PG8_STAGE(PG8_SB(0, 0), b2, voffB);
            PG8_BAR; PG8_WAIT_L(0); PG8_MMA(0, 1, At, B1); PG8_BAR;
            PG8_LDA(At, 0, 1); PG8_STAGE(PG8_SA(0, 0), a2, voffA);
            PG8_BAR; PG8_WAIT_L(0); PG8_MMA(1, 0, At, B0); PG8_BAR; PG8_SCHED;
            PG8_STAGE(PG8_SB(0, 1), b2 + hstep, voffB);
            PG8_WAIT_V(6); PG8_BAR; PG8_MMA(1, 1, At, B1); PG8_BAR;
            PG8_LDB(B0, 1, 0); PG8_SCHED; PG8_LDA(At, 1, 0); PG8_STAGE(PG8_SA(0, 1), a2 + hstep, voffA);
            PG8_WAIT_L(8); PG8_BAR; PG8_WAIT_L(0); PG8_MMA(0, 0, At, B0); PG8_BAR; PG8_SCHED;
            PG8_LDB(B1, 1, 1); PG8_STAGE(PG8_SB(1, 0), b3, voffB);
            PG8_BAR; PG8_WAIT_L(0); PG8_MMA(0, 1, At, B1); PG8_BAR;
            PG8_LDA(At, 1, 1); PG8_STAGE(PG8_SA(1, 0), a3, voffA);
            PG8_BAR; PG8_WAIT_L(0); PG8_MMA(1, 0, At, B0); PG8_BAR; PG8_SCHED;
            PG8_STAGE(PG8_SB(1, 1), b3 + hstep, voffB);
            PG8_WAIT_V(6); PG8_BAR; PG8_MMA(1, 1, At, B1); PG8_BAR;
            }
        }
        if constexpr (ALIGN_EPI) { if (wr == 0) PG8_BAR; }
        if constexpr (!Epi::AFTER_DRAIN) { E(acc, cur, wr, wc, fr, fq); S.done(cur); }
        if (!has_next) break;
#pragma unroll
        for (int a = 0; a < 2; ++a)
#pragma unroll
            for (int b = 0; b < 2; ++b)
#pragma unroll
                for (int m = 0; m < 4; ++m)
#pragma unroll
                    for (int n = 0; n < 2; ++n) acc[a][b][m][n] = (f32x4){0.f, 0.f, 0.f, 0.f};
        cur = nxt; cA = nA; cB = nB; ++ui;
        if constexpr (ALIGN_EPI) { if (wr == 1) PG8_BAR; }
    }
    PG8_WAIT_V(0);
    if constexpr (!ALIGN_EPI) { if (wr == 0) PG8_BAR; }
    PG8_BAR;
    if constexpr (Epi::AFTER_DRAIN) { E.fused(acc, cur, wr, wc, fr, fq, lds, wid, lane); S.done(cur); }
#undef PG8_SA
#undef PG8_SB
#undef PG8_STAGE
#undef PG8_LDA
#undef PG8_LDB
#undef PG8_MMA
#undef PG8_WAIT_V
#undef PG8_WAIT_L
#undef PG8_BAR
#undef PG8_SCHED
}
}
#include <hip/hip_bf16.h>
#include <cmath>
namespace attn_body {
using bf16=__hip_bfloat16;
using bf16x8=__attribute__((ext_vector_type(8)))short;
using s16x4=__attribute__((ext_vector_type(4)))short;
using f32x16=__attribute__((ext_vector_type(16)))float;
using u32x4=__attribute__((ext_vector_type(4)))unsigned;
constexpr int BATCH=2,NHEAD=8,SEQ=16384,D=64,QP=1792,KP=1792,OP=1024;
constexpr int NW=8,QBLK=32,QB=QBLK*NW,KVBLK=64,NQB=SEQ/QB;
constexpr int ATTN_UNIT_ROWS=QB;
__device__ __forceinline__ int crow(int r,int hi){return (r&3)+8*(r>>2)+4*hi;}
#define SBAR() __builtin_amdgcn_sched_barrier(0)
__device__ __forceinline__ void cmask(f32x16&p0,f32x16&p1,int jb,int qrel,int hi){
  const float NEG=-INFINITY; int kb=64*jb+4*hi;
  #pragma unroll
  for(int r=0;r<16;++r){int kv=kb+(r&3)+8*(r>>2); if(kv>qrel)p0[r]=NEG; if(kv+32>qrel)p1[r]=NEG;}
}

constexpr int NSLOT=3, SLOTB=8192;
constexpr int LDS_K=0, LDS_V=NSLOT*SLOTB, LDS_WS=2*NSLOT*SLOTB, LDS_OST=LDS_WS+NW*64*4, LDS_BYTES=LDS_OST+NW*4096;
constexpr float C2=0.125f*1.4426950408889634f;
__device__ __forceinline__ void glds16(const void*gsrc,unsigned lds_dst){unsigned keep;
  asm volatile("s_mov_b32 %0, m0\n\ts_mov_b32 m0, %2\n\ts_nop 0\n\tglobal_load_lds_dwordx4 %1, off\n\ts_mov_b32 m0, %0":"=&s"(keep):"v"(gsrc),"s"(lds_dst):"memory");}
__device__ __forceinline__ float max3f(float a,float b,float c){float r;asm("v_max3_f32 %0, %1, %2, %3":"=v"(r):"v"(a),"v"(b),"v"(c));return r;}
__device__ __forceinline__ float max2f(float a,float b){float r;asm("v_max_f32_e32 %0, %1, %2":"=v"(r):"v"(a),"v"(b));return r;}
__device__ __forceinline__ float fadd_s(float a,float b){float r;asm("v_add_f32_e32 %0, %1, %2":"=v"(r):"v"(a),"v"(b));return r;}
__device__ __forceinline__ float fsub_s(float a,float b){float r;asm("v_sub_f32_e32 %0, %1, %2":"=v"(r):"v"(a),"v"(b));return r;}
typedef float f32x2_t __attribute__((ext_vector_type(2))); typedef __bf16 bf16x2_t __attribute__((ext_vector_type(2)));
__device__ __forceinline__ unsigned cvtpk_s(float lo,float hi){f32x2_t v={lo,hi};bf16x2_t b=__builtin_convertvector(v,bf16x2_t);return __builtin_bit_cast(unsigned,b);}
#define WAIT_BAR(N) asm volatile("s_waitcnt vmcnt(" #N ") lgkmcnt(0)\n\ts_barrier":::"memory")

__device__ __forceinline__ void qkt(f32x16&p0,f32x16&p1,const char*Kslot,const bf16x8*qr,const f32x16&negm,int r32,int hi){
  const char*kb=Kslot+hi*1024+r32*16;
  #pragma unroll
  for(int d0=0;d0<4;++d0){
    const bf16x8 b0=*reinterpret_cast<const bf16x8*>(kb+d0*2048);
    const bf16x8 b1=*reinterpret_cast<const bf16x8*>(kb+d0*2048+512);
    if(d0==0){p0=__builtin_amdgcn_mfma_f32_32x32x16_bf16(b0,qr[0],negm,0,0,0);p1=__builtin_amdgcn_mfma_f32_32x32x16_bf16(b1,qr[0],negm,0,0,0);}
    else{p0=__builtin_amdgcn_mfma_f32_32x32x16_bf16(b0,qr[d0],p0,0,0,0);p1=__builtin_amdgcn_mfma_f32_32x32x16_bf16(b1,qr[d0],p1,0,0,0);}}
}
typedef __attribute__((address_space(3))) const char* lds_cptr;
typedef short v4i16_t __attribute__((ext_vector_type(4)));
__device__ __forceinline__ void kload8(bf16x8*kf,lds_cptr kp){
  kf[0]=*(const __attribute__((address_space(3))) bf16x8*)(kp);      kf[1]=*(const __attribute__((address_space(3))) bf16x8*)(kp+512);
  kf[2]=*(const __attribute__((address_space(3))) bf16x8*)(kp+2048); kf[3]=*(const __attribute__((address_space(3))) bf16x8*)(kp+2560);
  kf[4]=*(const __attribute__((address_space(3))) bf16x8*)(kp+4096); kf[5]=*(const __attribute__((address_space(3))) bf16x8*)(kp+4608);
  kf[6]=*(const __attribute__((address_space(3))) bf16x8*)(kp+6144); kf[7]=*(const __attribute__((address_space(3))) bf16x8*)(kp+6656);
}
__device__ __forceinline__ void kload2(bf16x8*kf,lds_cptr kp,int j){ kf[2*j]=*(const __attribute__((address_space(3))) bf16x8*)(kp+j*2048); kf[2*j+1]=*(const __attribute__((address_space(3))) bf16x8*)(kp+j*2048+512); }
__device__ __forceinline__ s16x4 vtr(lds_cptr p){ return __builtin_bit_cast(s16x4,__builtin_amdgcn_ds_read_tr16_b64_v4i16((__attribute__((address_space(3))) v4i16_t*)p)); }
__device__ __forceinline__ float rowmax(const f32x16&p0,const f32x16&p1){
  float a=max3f(p0[0],p0[1],p1[0]),b=max3f(p0[2],p0[3],p1[1]);a=max3f(a,p1[2],p1[3]);
  #pragma unroll
  for(int r=4;r<16;r+=4){a=max3f(a,p0[r],p0[r+1]);b=max3f(b,p0[r+2],p0[r+3]);a=max3f(a,p1[r],p1[r+1]);b=max3f(b,p1[r+2],p1[r+3]);}
  const float m=max2f(a,b);
  auto rr=__builtin_amdgcn_permlane32_swap(__float_as_uint(m),__float_as_uint(m),false,false);
  return max2f(__uint_as_float(rr[0]),__uint_as_float(rr[1]));
}
__device__ __forceinline__ void pv(f32x16*o,int vb,bf16x8 pa0,bf16x8 pa1,bf16x8 pa2,bf16x8 pa3){
  #pragma unroll
  for(int d0=0;d0<2;++d0){s16x4 lo[4],hi[4];
    #pragma unroll
    for(int ks=0;ks<4;++ks){
      asm volatile("ds_read_b64_tr_b16 %0,%1 offset:%c2":"=&v"(lo[ks]):"v"(vb),"i"(d0*4096+ks*1024):"memory");
      asm volatile("ds_read_b64_tr_b16 %0,%1 offset:%c2":"=&v"(hi[ks]):"v"(vb),"i"(d0*4096+ks*1024+512):"memory");}
    asm volatile("s_waitcnt lgkmcnt(0)":::"memory");SBAR();
    #define PK(k) (bf16x8){lo[k][0],lo[k][1],lo[k][2],lo[k][3],hi[k][0],hi[k][1],hi[k][2],hi[k][3]}
    o[d0]=__builtin_amdgcn_mfma_f32_32x32x16_bf16(pa0,PK(0),o[d0],0,0,0);
    o[d0]=__builtin_amdgcn_mfma_f32_32x32x16_bf16(pa1,PK(1),o[d0],0,0,0);
    o[d0]=__builtin_amdgcn_mfma_f32_32x32x16_bf16(pa2,PK(2),o[d0],0,0,0);
    o[d0]=__builtin_amdgcn_mfma_f32_32x32x16_bf16(pa3,PK(3),o[d0],0,0,0);
    #undef PK
  }
}

#ifndef ATTN_STORE16
#define ATTN_STORE16(p,v) (*(u32x4*)(p)=(v))
#endif
template<int THRL> __device__ __forceinline__ void attn_unit(int b,int h,int kvh,int qb,const bf16*Q,const bf16*__restrict__ K,const bf16*__restrict__ V,bf16*O,char*shm){
  const int tid=threadIdx.x,lane=tid&63,r32=lane&31,hi=lane>>5; const int wid=__builtin_amdgcn_readfirstlane(tid>>6);
  const long rowbase=(long)b*SEQ; const int q0=qb*QB;
  const bf16*Qw=Q+(rowbase+q0+wid*QBLK)*QP+h*D;
  const bf16*Kh=K+rowbase*KP+kvh*D,*Vh=V+rowbase*KP+kvh*D;
  const unsigned lds0=(unsigned)(uintptr_t)shm;
  float*wsf=(float*)(shm+LDS_WS)+wid*64;
  const bf16*ksrc=Kh+(long)lane*KP+wid*8;
  const bf16*vsrc=Vh+(long)(16*(wid&3)+(lane>>2))*KP+(wid>>2)*32+(lane&3)*8;
  const unsigned kdst=lds0+LDS_K+wid*1024, vdst=lds0+LDS_V+wid*1024;
  #define DMA_K(t,slot) glds16(ksrc+(long)(t)*KVBLK*KP,(unsigned)__builtin_amdgcn_readfirstlane(kdst+(slot)))
  #define DMA_V(t,slot) glds16(vsrc+(long)(t)*KVBLK*KP,(unsigned)__builtin_amdgcn_readfirstlane(vdst+(slot)))
  const int vb0=(int)(lds0+LDS_V)+((lane>>4)&1)*32+(lane&3)*8+(4*hi+((lane&15)>>2))*64;
  const char*Kbase=shm+LDS_K; bf16x8 kf[8];
  const lds_cptr shm3=(lds_cptr)shm; const lds_cptr kp0=shm3+LDS_K+hi*1024+r32*16; const lds_cptr vp0=shm3+LDS_V+((lane>>4)&1)*32+(lane&3)*8+(4*hi+((lane&15)>>2))*64;
  const int NT=SEQ/KVBLK;
  DMA_K(0,0);DMA_V(0,0);DMA_K(1,SLOTB);
  bf16x8 qr[4];
  #pragma unroll
  for(int d0=0;d0<4;++d0)qr[d0]=*reinterpret_cast<const bf16x8*>(&Qw[(long)r32*QP+d0*16+hi*8]);
  float mhat=0.f,l_reg=0.f;f32x16 o[2];o[0]=f32x16{};o[1]=f32x16{};f32x16 negm=f32x16{};asm volatile("":"+v"(negm));
  const int qrel=wid*QBLK+r32;
  #define CMASK(P0,P1,t) do{}while(0)
  bool resc=false;
  #define START(P0,P1) do{ const float rm=rowmax(P0,P1); resc=false; \
    { const float dl=rm; mhat=fadd_s(mhat,dl); \
      _Pragma("unroll") for(int r=0;r<16;++r){P0[r]=fsub_s(P0[r],dl);P1[r]=fsub_s(P1[r],dl);} \
      _Pragma("unroll") for(int r=0;r<16;++r)negm[r]=-mhat; asm volatile("":"+v"(negm)); } \
    _Pragma("unroll") for(int r=0;r<16;++r)P0[r]=__builtin_amdgcn_exp2f(P0[r]); }while(0)
  #define RESC() do{ if(resc){ asm volatile("s_waitcnt lgkmcnt(0)":::"memory"); \
      _Pragma("unroll") for(int d_=0;d_<2;++d_) _Pragma("unroll") for(int r=0;r<16;++r)o[d_][r]*=wsf[crow(r,hi)]; } }while(0)
  f32x16 pA0,pA1,pB0,pB1;
  int sl_prev=0,sl_cur=0,sl_next=SLOTB;
  #define ROT() do{sl_prev=sl_cur;sl_cur=sl_next;sl_next=(sl_next==(NSLOT-1)*SLOTB)?0:sl_next+SLOTB;}while(0)
  DMA_K(2,2*SLOTB);
  WAIT_BAR(3);
  qkt(pA0,pA1,Kbase,qr,negm,r32,hi);asm volatile("s_nop 15\n\ts_nop 7":"+v"(pA0),"+v"(pA1));CMASK(pA0,pA1,0);
  START(pA0,pA1);
  _Pragma("unroll") for(int r=0;r<16;++r)pA1[r]=__builtin_amdgcn_exp2f(pA1[r]);
  WAIT_BAR(0);
  DMA_K(3,0);DMA_V(1,SLOTB);
  ROT();
  kload8(kf,kp0+sl_cur);
  WAIT_BAR(2);
  s16x4 vlo[8],vhi[8]; u32x4 pw0,pw1,pw2,pw3;
  #define PKW(P,B) cvtpk_s(P[B],P[B+1])
  #define PAF(k) __builtin_bit_cast(bf16x8,pw##k)
  #define VFR(i) (bf16x8){vlo[i][0],vlo[i][1],vlo[i][2],vlo[i][3],vhi[i][0],vhi[i][1],vhi[i][2],vhi[i][3]}
  #define PIN(x) asm volatile("":"+v"(x))
  #define MX3(a,b,c) __builtin_fmaxf(__builtin_fmaxf((a),(b)),(c))
  #define GAPA(MF,A0,A1,A2,A3,W0,W1,PW) do{ MF; sacc+=A0; sacc+=A1; sacc+=A2; sacc+=A3; PIN(sacc); W0; W1; PIN(PW); SBAR(); }while(0)
  #define EX(v) __builtin_amdgcn_exp2f(v)
  #define GAPB(MF,X,B) do{ MF; X[B]=EX(X[B]); X[B+1]=EX(X[B+1]); X[B+2]=EX(X[B+2]); X[B+3]=EX(X[B+3]); PIN(X); SBAR(); }while(0)
  #define VRD(i) do{ vlo[i]=vtr(vp_+(((i)>>2)*4096+((i)&3)*1024)); vhi[i]=vtr(vp_+(((i)>>2)*4096+((i)&3)*1024+512)); }while(0)
  #define KRD(G,j) do{ if(G){ kload2(kf,kp0+sl_next,j); SBAR(); } }while(0)
  #define STEP(C0,C1,P0,P1,t,GK,GV,GL) do{ SBAR(); \
    const lds_cptr vp_=vp0+sl_prev; \
    VRD(0); SBAR(); float sacc=(P0[0]+P0[1]); \
    GAPA(C0=__builtin_amdgcn_mfma_f32_32x32x16_bf16(kf[0],qr[0],negm,0,0,0), P0[2],P0[3],P0[4],P0[5],     pw0[0]=PKW(P0,0), pw0[1]=PKW(P0,2), pw0); \
    VRD(4); SBAR(); GAPA(C1=__builtin_amdgcn_mfma_f32_32x32x16_bf16(kf[1],qr[0],negm,0,0,0), P0[6],P0[7],P0[8],P0[9],     pw0[2]=PKW(P0,4), pw0[3]=PKW(P0,6), pw0); \
    VRD(1); SBAR(); GAPA(C0=__builtin_amdgcn_mfma_f32_32x32x16_bf16(kf[2],qr[1],C0,0,0,0),   P0[10],P0[11],P0[12],P0[13], pw1[0]=PKW(P0,8), pw1[1]=PKW(P0,10), pw1); \
    VRD(5); SBAR(); GAPA(C1=__builtin_amdgcn_mfma_f32_32x32x16_bf16(kf[3],qr[1],C1,0,0,0),   P0[14],P0[15],P1[0],P1[1],   pw1[2]=PKW(P0,12),pw1[3]=PKW(P0,14), pw1); \
    VRD(2); SBAR(); GAPA(C0=__builtin_amdgcn_mfma_f32_32x32x16_bf16(kf[4],qr[2],C0,0,0,0),   P1[2],P1[3],P1[4],P1[5],     pw2[0]=PKW(P1,0), pw2[1]=PKW(P1,2), pw2); \
    VRD(6); SBAR(); GAPA(C1=__builtin_amdgcn_mfma_f32_32x32x16_bf16(kf[5],qr[2],C1,0,0,0),   P1[6],P1[7],P1[8],P1[9],     pw2[2]=PKW(P1,4), pw2[3]=PKW(P1,6), pw2); \
    VRD(3); SBAR(); GAPA(C0=__builtin_amdgcn_mfma_f32_32x32x16_bf16(kf[6],qr[3],C0,0,0,0),   P1[10],P1[11],P1[12],P1[13], pw3[0]=PKW(P1,8), pw3[1]=PKW(P1,10), pw3); \
    VRD(7); SBAR(); GAPA(C1=__builtin_amdgcn_mfma_f32_32x32x16_bf16(kf[7],qr[3],C1,0,0,0),   P1[14],P1[15],0.f,0.f,       pw3[2]=PKW(P1,12),pw3[3]=PKW(P1,14), pw3); \
    l_reg+=sacc; \
    if(GK){DMA_K((t)+3,sl_cur);} if(GV){DMA_V((t)+1,sl_next);} \
    CMASK(C0,C1,t); \
    { float a=MX3(C0[0],C0[1],C1[0]),b=MX3(C0[2],C0[3],C1[1]); a=MX3(a,C1[2],C1[3]); \
      _Pragma("unroll") for(int r=4;r<16;r+=4){a=MX3(a,C0[r],C0[r+1]);b=MX3(b,C0[r+2],C0[r+3]);a=MX3(a,C1[r],C1[r+1]);b=MX3(b,C1[r+2],C1[r+3]);} \
      float rm=__builtin_fmaxf(a,b); { auto rr=__builtin_amdgcn_permlane32_swap(__float_as_uint(rm),__float_as_uint(rm),false,false); rm=__builtin_fmaxf(__uint_as_float(rr[0]),__uint_as_float(rr[1])); } \
      resc=false; \
      if(__builtin_expect(__any(rm>(float)THRL),0)){ const float dl=__builtin_fmaxf(rm,0.f); mhat+=dl; \
        _Pragma("unroll") for(int r=0;r<16;++r){C0[r]-=dl;C1[r]-=dl;} \
        _Pragma("unroll") for(int r=0;r<16;++r)negm[r]=-mhat; asm volatile("":"+v"(negm)); \
        const float f=__builtin_amdgcn_exp2f(-dl); l_reg*=f; if(hi==0)wsf[r32]=f; resc=true; } } \
    SBAR(); \
    GAPB(o[0]=__builtin_amdgcn_mfma_f32_32x32x16_bf16(PAF(0),VFR(0),o[0],0,0,0), C0,0); \
    GAPB(o[1]=__builtin_amdgcn_mfma_f32_32x32x16_bf16(PAF(0),VFR(4),o[1],0,0,0), C0,4); \
    KRD(GL,0); GAPB(o[0]=__builtin_amdgcn_mfma_f32_32x32x16_bf16(PAF(1),VFR(1),o[0],0,0,0), C0,8); \
    KRD(GL,1); GAPB(o[1]=__builtin_amdgcn_mfma_f32_32x32x16_bf16(PAF(1),VFR(5),o[1],0,0,0), C0,12); \
    KRD(GL,2); GAPB(o[0]=__builtin_amdgcn_mfma_f32_32x32x16_bf16(PAF(2),VFR(2),o[0],0,0,0), C1,0); \
    KRD(GL,3); GAPB(o[1]=__builtin_amdgcn_mfma_f32_32x32x16_bf16(PAF(2),VFR(6),o[1],0,0,0), C1,4); \
    GAPB(o[0]=__builtin_amdgcn_mfma_f32_32x32x16_bf16(PAF(3),VFR(3),o[0],0,0,0), C1,8); \
    GAPB(o[1]=__builtin_amdgcn_mfma_f32_32x32x16_bf16(PAF(3),VFR(7),o[1],0,0,0), C1,12); \
    }while(0)
  int t=1;
  #undef CMASK
  #define CMASK(P0,P1,t) do{}while(0)
  for(;t+5<NT;t+=2){
    STEP(pB0,pB1,pA0,pA1,t,true,true,true);     WAIT_BAR(2); RESC(); ROT();
    STEP(pA0,pA1,pB0,pB1,t+1,true,true,true);   WAIT_BAR(2); RESC(); ROT();
  }
  #undef CMASK
  #define CMASK(P0,P1,t) do{}while(0)
  #define ENDW(tt) do{ if((tt)+3<NT){WAIT_BAR(2);} else if((tt)+2<NT){WAIT_BAR(1);} else {WAIT_BAR(0);} }while(0)
  for(;t+1<NT;t+=2){
    STEP(pB0,pB1,pA0,pA1,t,(t+3<NT),(t+1<NT),(t+1<NT));       ENDW(t);   RESC(); ROT();
    STEP(pA0,pA1,pB0,pB1,t+1,(t+4<NT),(t+2<NT),(t+2<NT));     ENDW(t+1); RESC(); ROT();
  }
  STEP(pB0,pB1,pA0,pA1,NT-1,false,false,false); RESC();
  { float sacc=pB0[0]+pB0[1]; _Pragma("unroll") for(int r=2;r<16;++r)sacc+=pB0[r]; _Pragma("unroll") for(int r=0;r<16;++r)sacc+=pB1[r]; l_reg+=sacc;
    pw0=(u32x4){PKW(pB0,0),PKW(pB0,2),PKW(pB0,4),PKW(pB0,6)};pw1=(u32x4){PKW(pB0,8),PKW(pB0,10),PKW(pB0,12),PKW(pB0,14)};pw2=(u32x4){PKW(pB1,0),PKW(pB1,2),PKW(pB1,4),PKW(pB1,6)};pw3=(u32x4){PKW(pB1,8),PKW(pB1,10),PKW(pB1,12),PKW(pB1,14)};
    SBAR(); pv(o,vb0+sl_cur,PAF(0),PAF(1),PAF(2),PAF(3)); }
  #undef PKW
  #undef PAF
  #undef VFR
  #undef PIN
  #undef MX3
  #undef GAPA
  #undef GAPB
  #undef EX
  #undef VRD
  #undef KRD
  #undef STEP
  #undef ENDW
  {auto rr=__builtin_amdgcn_permlane32_swap(__float_as_uint(l_reg),__float_as_uint(l_reg),false,false);l_reg=__uint_as_float(rr[0])+__uint_as_float(rr[1]);}
  if(hi==0)wsf[32+r32]=l_reg;asm volatile("s_waitcnt lgkmcnt(0)":::"memory");
  float rli[16];
  #pragma unroll
  for(int r=0;r<16;++r)rli[r]=__builtin_amdgcn_rcpf(wsf[32+crow(r,hi)]);
  bf16*Ow=O+(rowbase+q0+wid*QBLK)*OP+h*D;
  { bf16*stg=(bf16*)(shm+LDS_OST)+wid*2048;
    #pragma unroll
    for(int r=0;r<16;++r){const int orow=crow(r,hi);
      #pragma unroll
      for(int d0=0;d0<2;++d0)stg[orow*64+d0*32+r32]=__float2bfloat16(o[d0][r]*rli[r]);}
    asm volatile("s_waitcnt lgkmcnt(0)":::"memory");
    #pragma unroll
    for(int i=0;i<4;++i){const int row=i*8+(lane>>3),ch=lane&7; const u32x4 v=*(const u32x4*)(stg+row*64+ch*8); ATTN_STORE16(Ow+(long)row*OP+ch*8,v);} }
  asm volatile("s_waitcnt lgkmcnt(0)\n\ts_barrier":::"memory");
  #undef DMA_K
  #undef DMA_V
  #undef CMASK
  #undef START
  #undef RESC
  #undef ROT
}
constexpr int ATTN_LDS_BYTES=LDS_BYTES;
#undef SBAR
#undef WAIT_BAR
}
#define LAS __attribute__((address_space(3)))
typedef unsigned short bf16;
typedef unsigned u32x4_t __attribute__((ext_vector_type(4)));
typedef unsigned u32x2_t __attribute__((ext_vector_type(2)));
typedef float f32x4_t __attribute__((ext_vector_type(4)));
typedef short bf16x8_t __attribute__((ext_vector_type(8)));
typedef short s16x4_t __attribute__((ext_vector_type(4)));

constexpr int NWAVES = 8, NTHR = 512;
constexpr int BATCH = 2, SEQ = 16384, DMODEL = 1024, M = BATCH * SEQ;
constexpr int L0N = 1792, FFH = 2816, L1QKV = 4096, RVW = 2048;
constexpr float ALPHA = 1.4142135623730951f;
constexpr float LN_EPS = 1e-5f, RMS_EPS = 1e-6f;
constexpr int LDS_BYTES = 147456;
constexpr size_t MiB = 1u << 20;
constexpr size_t WS_W0IN = 0, WS_W0OUT = 4 * MiB, WS_W0GU = 6 * MiB, WS_W0D = 17 * MiB, WS_W1IN = 23 * MiB, WS_W1OUT = 35 * MiB, WS_W1GU = 39 * MiB, WS_W1D = 50 * MiB;
constexpr size_t WS_TABA = 56 * MiB, WS_TABR = 57 * MiB, WS_BAR = 58 * MiB;
constexpr size_t WS_XB = 64 * MiB;
constexpr size_t WS_AC = 128 * MiB;
constexpr size_t WS_PROJ0 = 192 * MiB;
constexpr size_t WS_Y = 320 * MiB;
constexpr size_t WS_H = 128 * MiB;
constexpr size_t WS_OI = 128 * MiB;
constexpr size_t WS_QKV = 256 * MiB;
constexpr size_t WS_Y1 = 256 * MiB;
constexpr size_t WS_NEED = 512 * MiB;

__device__ __forceinline__ unsigned f2bf(float f) { unsigned u = __builtin_bit_cast(unsigned, f); return (u + 0x7fffu + ((u >> 16) & 1u)) >> 16; }
typedef float f32x2_cv __attribute__((ext_vector_type(2))); typedef __bf16 bf16x2_cv __attribute__((ext_vector_type(2)));
__device__ __forceinline__ unsigned pk2(float lo, float hi) { f32x2_cv v = {lo, hi}; bf16x2_cv b = __builtin_convertvector(v, bf16x2_cv); return __builtin_bit_cast(unsigned, b); }
__device__ __forceinline__ float bflo(unsigned w) { return __uint_as_float(w << 16); }
__device__ __forceinline__ float bfhi(unsigned w) { return __uint_as_float(w & 0xffff0000u); }
__device__ __forceinline__ float bf2f(unsigned short h) { return __uint_as_float(((unsigned)h) << 16); }
__device__ __forceinline__ float wave_sum(float v) {
#pragma unroll
    for (int o = 1; o < 64; o <<= 1) v += __shfl_xor(v, o);
    return v;
}
__device__ __forceinline__ float sigmoid_f(float v) { return __builtin_amdgcn_rcpf(1.0f + __builtin_amdgcn_exp2f(v * -1.4426950408889634f)); }
__device__ __forceinline__ s16x4_t tr_read(const LAS void* p) {
    typedef short v4i16_t __attribute__((ext_vector_type(4)));
    return __builtin_bit_cast(s16x4_t, __builtin_amdgcn_ds_read_tr16_b64_v4i16((LAS v4i16_t*)p));
}

__device__ __forceinline__ void p0_transpose_item(const float* W, int K, int N, bf16* WT, int mode, LAS float* scr, int item, int lane) {
    const int nblk = N / 32, kb = item / nblk, nb = item % nblk, k0 = 64 * kb, n0 = 32 * nb;
    const int r0 = (mode == 0) ? n0 : (256 * (n0 / 128) + (n0 % 128) + (mode == 2 ? 128 : 0));
#pragma unroll 8
    for (int i = 0; i < 32; ++i) { const int kk = 2 * i + (lane >> 5); scr[kk * 33 + (lane & 31)] = W[(size_t)(k0 + kk) * N + n0 + (lane & 31)]; }
    asm volatile("s_waitcnt lgkmcnt(0)" ::: "memory");
    const int c = lane & 7;
#pragma unroll
    for (int j = 0; j < 4; ++j) { const int n = (lane >> 3) + 8 * j; const LAS float* s = scr + (8 * c) * 33 + n;
        u32x4_t o; o.x = pk2(s[0 * 33], s[1 * 33]); o.y = pk2(s[2 * 33], s[3 * 33]); o.z = pk2(s[4 * 33], s[5 * 33]); o.w = pk2(s[6 * 33], s[7 * 33]);
        *(u32x4_t*)(WT + (size_t)(r0 + n) * K + k0 + 8 * c) = o; }
    asm volatile("s_waitcnt lgkmcnt(0)" ::: "memory");
}

struct Args { const float* in[28]; float* out; unsigned char* ws; int ph_lo, ph_hi; };

__device__ __forceinline__ void ln_row(const float* yrow, const float* g, const float* bta, float* of, bf16* ob, int lane) {
    const f32x4_t* xr = (const f32x4_t*)yrow + lane;
    f32x4_t v[4]; float s = 0.f;
#pragma unroll
    for (int j = 0; j < 4; ++j) { v[j] = xr[64 * j]; s += (v[j].x + v[j].y) + (v[j].z + v[j].w); }
    const float mean = wave_sum(s) * (1.f / DMODEL); float s2 = 0.f;
#pragma unroll
    for (int j = 0; j < 4; ++j) { v[j] = v[j] - mean; s2 += (v[j].x * v[j].x + v[j].y * v[j].y) + (v[j].z * v[j].z + v[j].w * v[j].w); }
    const float rstd = 1.f / sqrtf(wave_sum(s2) * (1.f / DMODEL) + LN_EPS);
#pragma unroll
    for (int j = 0; j < 4; ++j) {
        const f32x4_t gg = ((const f32x4_t*)g)[lane + 64 * j], bb = ((const f32x4_t*)bta)[lane + 64 * j];
        const f32x4_t o = v[j] * rstd * gg + bb;
        if (of) ((f32x4_t*)of)[lane + 64 * j] = o;
        if (ob) { u32x2_t w; w.x = pk2(o.x, o.y); w.y = pk2(o.z, o.w); ((u32x2_t*)ob)[lane + 64 * j] = w; }
    }
}
__device__ __forceinline__ void ln_phase(const float* Y, const float* g, const float* b, float* of, bf16* ob, int bid, int G, int wave, int lane) {
    const int NW = G * NWAVES, gw = bid * NWAVES + wave;
    f32x4_t gg[4], bb[4];
#pragma unroll
    for (int j = 0; j < 4; ++j) { gg[j] = ((const f32x4_t*)g)[lane + 64 * j]; bb[j] = ((const f32x4_t*)b)[lane + 64 * j]; }
    for (int m0 = gw; m0 < M; m0 += 4 * NW) {
        f32x4_t v[4][4]; float s[4];
#pragma unroll
        for (int r = 0; r < 4; ++r) { const f32x4_t* xr = (const f32x4_t*)(Y + (size_t)(m0 + r * NW) * DMODEL) + lane;
#pragma unroll
            for (int j = 0; j < 4; ++j) v[r][j] = xr[64 * j]; }
#pragma unroll
        for (int r = 0; r < 4; ++r) { float t = 0.f;
#pragma unroll
            for (int j = 0; j < 4; ++j) t += (v[r][j].x + v[r][j].y) + (v[r][j].z + v[r][j].w);
            s[r] = t; }
#pragma unroll
        for (int o = 1; o < 64; o <<= 1) {
#pragma unroll
            for (int r = 0; r < 4; ++r) s[r] += __shfl_xor(s[r], o); }
        float q[4];
#pragma unroll
        for (int r = 0; r < 4; ++r) { const float mean = s[r] * (1.f / DMODEL); float t = 0.f;
#pragma unroll
            for (int j = 0; j < 4; ++j) { v[r][j] = v[r][j] - mean; t += (v[r][j].x * v[r][j].x + v[r][j].y * v[r][j].y) + (v[r][j].z * v[r][j].z + v[r][j].w * v[r][j].w); }
            q[r] = t; }
#pragma unroll
        for (int o = 1; o < 64; o <<= 1) {
#pragma unroll
            for (int r = 0; r < 4; ++r) q[r] += __shfl_xor(q[r], o); }
#pragma unroll
        for (int r = 0; r < 4; ++r) { const float rstd = 1.f / sqrtf(q[r] * (1.f / DMODEL) + LN_EPS); const size_t ro = (size_t)(m0 + r * NW) * DMODEL;
#pragma unroll
            for (int j = 0; j < 4; ++j) { const f32x4_t o = v[r][j] * rstd * gg[j] + bb[j];
                if (of) ((f32x4_t*)(of + ro))[lane + 64 * j] = o;
                if (ob) { u32x2_t w; w.x = pk2(o.x, o.y); w.y = pk2(o.z, o.w); ((u32x2_t*)(ob + ro))[lane + 64 * j] = w; } } }
    }
}

__device__ __forceinline__ void qk_norm_rope(bf16* P0, const float* qg, const float* kg, const float2* tabA, int gtid, int gthreads) {
    const int sub = gtid & 7, s3 = sub & 3, ngrp = gthreads >> 3;
    for (int it0 = gtid >> 3; it0 < M * 10; it0 += 4 * ngrp) {
        u32x4_t wv[4];
#pragma unroll
        for (int u = 0; u < 4; ++u) { const int it = it0 + u * ngrp, tok = it / 10, hh = it - tok * 10; wv[u] = *(const u32x4_t*)(P0 + (size_t)tok * L0N + hh * 64 + 8 * sub); }
#pragma unroll
        for (int u = 0; u < 4; ++u) {
            const int it = it0 + u * ngrp, tok = it / 10, hh = it - tok * 10;
            bf16* p = P0 + (size_t)tok * L0N + hh * 64 + 8 * sub;
            const u32x4_t w = wv[u];
            float v[8] = {bflo(w.x), bfhi(w.x), bflo(w.y), bfhi(w.y), bflo(w.z), bfhi(w.z), bflo(w.w), bfhi(w.w)};
            float ss = 0.f;
#pragma unroll
            for (int j = 0; j < 8; ++j) ss += v[j] * v[j];
            ss += __shfl_xor(ss, 1); ss += __shfl_xor(ss, 2); ss += __shfl_xor(ss, 4);
            const float r = 1.0f / sqrtf(ss * (1.f / 64.f) + RMS_EPS);
            const float* g = ((hh < 8) ? qg : kg) + 8 * sub;
            const f32x4_t g0 = *(const f32x4_t*)g, g1 = *(const f32x4_t*)(g + 4);
            const float gv[8] = {g0.x, g0.y, g0.z, g0.w, g1.x, g1.y, g1.z, g1.w};
            const float sc = (hh < 8) ? (0.125f * 1.4426950408889634f) : 1.0f;
            const int s = tok % SEQ, row = s >> 6, col = s & 63;
            const f32x4_t* tp = (const f32x4_t*)(tabA + ((s3 < 2) ? (row * 16 + 8 * s3) : (col * 16 + 8 * (s3 - 2))));
            const f32x4_t t0 = tp[0], t1 = tp[1], t2 = tp[2], t3 = tp[3];
            const float cs[8] = {t0.x, t0.z, t1.x, t1.z, t2.x, t2.z, t3.x, t3.z}, sn[8] = {t0.y, t0.w, t1.y, t1.w, t2.y, t2.w, t3.y, t3.w};
            float o[8];
#pragma unroll
            for (int j = 0; j < 8; ++j) {
                const float y = v[j] * r * gv[j];
                const float pv = __shfl_xor(y, 4);
                o[j] = ((sub < 4) ? (y * cs[j] - pv * sn[j]) : (pv * sn[j] + y * cs[j])) * sc;
            }
            u32x4_t wo; wo.x = pk2(o[0], o[1]); wo.y = pk2(o[2], o[3]); wo.z = pk2(o[4], o[5]); wo.w = pk2(o[6], o[7]);
            *(u32x4_t*)p = wo;
        }
    }
}

__device__ __forceinline__ void conv_phase(char* lds, const bf16* P0, const float* dww, const float* dwb, const float* ng, const float* nb, bf16* AC, int bid, int G) {
    const int tid = threadIdx.x, lane = tid & 63, wave = tid >> 6;
    bf16* zin = (bf16*)lds;
    float* cz = (float*)(lds + 63488);
    const int cp = tid & 255, half = tid >> 8;
    for (int tile = bid; tile < M / 32; tile += G) {
        const int tok0 = tile * 32, b = tok0 / SEQ, s0 = tok0 % SEQ;
        for (int it = tid; it < 62 * 64; it += NTHR) {
            const int r = it >> 6, cgp = it & 63, sp = s0 - 15 + r;
            u32x4_t w = (u32x4_t){0u, 0u, 0u, 0u};
            if (sp >= 0 && sp < SEQ) {
                const bf16* pr = P0 + (size_t)(b * SEQ + sp) * L0N;
                const u32x4_t a = *(const u32x4_t*)(pr + 768 + 8 * cgp), g = *(const u32x4_t*)(pr + 1280 + 8 * cgp);
                w.x = pk2(bflo(a.x) * sigmoid_f(bflo(g.x)), bfhi(a.x) * sigmoid_f(bfhi(g.x)));
                w.y = pk2(bflo(a.y) * sigmoid_f(bflo(g.y)), bfhi(a.y) * sigmoid_f(bfhi(g.y)));
                w.z = pk2(bflo(a.z) * sigmoid_f(bflo(g.z)), bfhi(a.z) * sigmoid_f(bfhi(g.z)));
                w.w = pk2(bflo(a.w) * sigmoid_f(bflo(g.w)), bfhi(a.w) * sigmoid_f(bfhi(g.w)));
            }
            *(u32x4_t*)(zin + r * 512 + 8 * cgp) = w;
        }
        __syncthreads();
        {
            float a0[16], a1[16];
            const float b0 = dwb[2 * cp], b1 = dwb[2 * cp + 1];
#pragma unroll
            for (int t = 0; t < 16; ++t) { a0[t] = b0; a1[t] = b1; }
            float w0[31], w1[31];
#pragma unroll
            for (int j = 0; j < 31; ++j) { const float2 ww = *(const float2*)(dww + j * 512 + 2 * cp); w0[j] = ww.x; w1[j] = ww.y; }
#pragma unroll
            for (int r = 0; r < 46; ++r) {
                const unsigned zz = *(const unsigned*)(zin + (16 * half + r) * 512 + 2 * cp);
                const float z0 = bflo(zz), z1 = bfhi(zz);
#pragma unroll
                for (int t = 0; t < 16; ++t) { const int j = r - t; if (j >= 0 && j < 31) { a0[t] += z0 * w0[j]; a1[t] += z1 * w1[j]; } }
            }
#pragma unroll
            for (int t = 0; t < 16; ++t) *(float2*)(cz + (16 * half + t) * 512 + 2 * cp) = make_float2(a0[t], a1[t]);
        }
        __syncthreads();
#pragma unroll
        for (int q = 0; q < 4; ++q) {
            const int tk = 4 * wave + q;
            const f32x4_t v0 = *(const f32x4_t*)(cz + tk * 512 + 8 * lane), v1 = *(const f32x4_t*)(cz + tk * 512 + 8 * lane + 4);
            const float mean = wave_sum((v0.x + v0.y) + (v0.z + v0.w) + (v1.x + v1.y) + (v1.z + v1.w)) * (1.f / 512.f);
            const f32x4_t d0 = v0 - mean, d1 = v1 - mean;
            const float var = wave_sum((d0.x * d0.x + d0.y * d0.y) + (d0.z * d0.z + d0.w * d0.w) + (d1.x * d1.x + d1.y * d1.y) + (d1.z * d1.z + d1.w * d1.w)) * (1.f / 512.f);
            const float rstd = 1.f / sqrtf(var + LN_EPS);
            const f32x4_t g0 = *(const f32x4_t*)(ng + 8 * lane), g1 = *(const f32x4_t*)(ng + 8 * lane + 4), e0 = *(const f32x4_t*)(nb + 8 * lane), e1 = *(const f32x4_t*)(nb + 8 * lane + 4);
            const f32x4_t y0 = d0 * rstd * g0 + e0, y1 = d1 * rstd * g1 + e1;
            u32x4_t w;
            w.x = pk2(y0.x * sigmoid_f(y0.x), y0.y * sigmoid_f(y0.y)); w.y = pk2(y0.z * sigmoid_f(y0.z), y0.w * sigmoid_f(y0.w));
            w.z = pk2(y1.x * sigmoid_f(y1.x), y1.y * sigmoid_f(y1.y)); w.w = pk2(y1.z * sigmoid_f(y1.z), y1.w * sigmoid_f(y1.w));
            *(u32x4_t*)(AC + (size_t)(tok0 + tk) * DMODEL + 512 + 8 * lane) = w;
        }
        __syncthreads();
    }
}

__device__ __forceinline__ void rope1_phase(bf16* QKV, const float2* tabR, int gtid, int gthreads) {
    for (int it = gtid; it < M * 128; it += gthreads) {
        const int grp = it & 15, hh = (it >> 4) & 7, tok = it >> 7;
        const int i0 = 8 * grp, s = tok % SEQ, row = s >> 6, col = s & 63;
        bf16* p = QKV + (size_t)tok * L1QKV + hh * 256 + i0;
        const u32x4_t x1 = *(const u32x4_t*)p, x2 = *(const u32x4_t*)(p + 128);
        const float2* tb = (i0 < 64) ? (tabR + row * 64 + i0) : (tabR + col * 64 + (i0 - 64));
        const float sc = (hh >= 4) ? 0.0625f : 1.0f;
        float a[8] = {bflo(x1.x), bfhi(x1.x), bflo(x1.y), bfhi(x1.y), bflo(x1.z), bfhi(x1.z), bflo(x1.w), bfhi(x1.w)};
        float b[8] = {bflo(x2.x), bfhi(x2.x), bflo(x2.y), bfhi(x2.y), bflo(x2.z), bfhi(x2.z), bflo(x2.w), bfhi(x2.w)};
        float oa[8], ob[8];
#pragma unroll
        for (int j = 0; j < 8; ++j) { const float2 cs = tb[j]; oa[j] = (a[j] * cs.x - b[j] * cs.y) * sc; ob[j] = (a[j] * cs.y + b[j] * cs.x) * sc; }
        u32x4_t w1, w2;
        w1.x = pk2(oa[0], oa[1]); w1.y = pk2(oa[2], oa[3]); w1.z = pk2(oa[4], oa[5]); w1.w = pk2(oa[6], oa[7]);
        w2.x = pk2(ob[0], ob[1]); w2.y = pk2(ob[2], ob[3]); w2.z = pk2(ob[4], ob[5]); w2.w = pk2(ob[6], ob[7]);
        *(u32x4_t*)p = w1; *(u32x4_t*)(p + 128) = w2;
    }
}

#define XB_TMO      128
#define XB_XCNT(j)  (256  + 64 * (j))
#define XB_XSUB(j)  (1280 + 64 * (j))
#define XB_XGEN(j)  (2304 + 64 * (j))
#define XB_TOP      3328
#define XB_TOPGEN   3392
#define XCD_BAR_WORDS 3456
#define XB_SPIN_CAP (1u << 18)

__device__ __forceinline__ unsigned xb_ld(unsigned* p)              { return __hip_atomic_load(p, __ATOMIC_RELAXED, __HIP_MEMORY_SCOPE_AGENT); }
__device__ __forceinline__ unsigned xb_add(unsigned* p, unsigned v) { return __hip_atomic_fetch_add(p, v, __ATOMIC_RELAXED, __HIP_MEMORY_SCOPE_AGENT); }
__device__ __forceinline__ unsigned xb_xcc_id() { return (unsigned)__builtin_amdgcn_s_getreg((3 << 11) | 20) & 0xFu; }
#define XB_SPIN(cond, bar) do { unsigned _sp = 0; while (cond) { __builtin_amdgcn_s_sleep(1); \
    if ((++_sp & 255u) == 0u) { if (xb_ld(&(bar)[XB_TMO])) break; if (_sp > XB_SPIN_CAP) { atomicAdd(&(bar)[XB_TMO], 1u); break; } } } } while (0)

struct XcdBarrier {
    unsigned* bar; unsigned x;
    volatile LAS unsigned* st;
};

__device__ __forceinline__ XcdBarrier xcd_barrier_post(unsigned* bar, volatile LAS unsigned* st) {
    XcdBarrier b; b.bar = bar; b.x = xb_xcc_id(); b.st = st;
    if (threadIdx.x == 0) (void)xb_add(&bar[XB_XCNT(b.x)], 1u);
    return b;
}
__device__ __forceinline__ void xcd_barrier_complete(unsigned* bar, unsigned x, unsigned& nloc, unsigned& nx) {
    const unsigned G = gridDim.x * gridDim.y * gridDim.z;
    unsigned sum, cnt, mine, sp = 0u;
    for (;;) {
        sum = 0u; cnt = 0u; mine = 0u;
#pragma unroll
        for (unsigned j = 0; j < 16; ++j) { const unsigned c = xb_ld(&bar[XB_XCNT(j)]); sum += c; cnt += (c > 0u) ? 1u : 0u; mine = (j == x) ? c : mine; }
        if (sum == G) break;
        __builtin_amdgcn_s_sleep(1);
        if ((++sp & 255u) == 0u) { if (xb_ld(&bar[XB_TMO])) break; if (sp > XB_SPIN_CAP) { atomicAdd(&bar[XB_TMO], 1u); break; } }
    }
    nloc = mine > 0u ? mine : 1u; nx = cnt > 0u ? cnt : 1u;
}

__device__ __forceinline__ void xcd_barrier(const XcdBarrier& b) {
    asm volatile("s_waitcnt vmcnt(0)" ::: "memory");
    __syncthreads();
    if (threadIdx.x == 0) {
        unsigned* bar = b.bar;
        __builtin_amdgcn_s_waitcnt(0);
        unsigned nloc = b.st[0], nx = b.st[1];
        if (nloc == 0u) { xcd_barrier_complete(bar, b.x, nloc, nx); b.st[0] = nloc; b.st[1] = nx; }
        const unsigned old = xb_add(&bar[XB_XSUB(b.x)], 1u);
        const unsigned gen = old / nloc;
        if (old + 1u == (gen + 1u) * nloc) {
            __builtin_amdgcn_fence(__ATOMIC_RELEASE, "agent");
            asm volatile("s_waitcnt vmcnt(0)" ::: "memory");
            const unsigned og = xb_add(&bar[XB_TOP], 1u);
            const unsigned tg = og / nx;
            if (og + 1u == (tg + 1u) * nx) xb_add(&bar[XB_TOPGEN], 1u);
            else XB_SPIN(xb_ld(&bar[XB_TOPGEN]) == tg, bar);
            __builtin_amdgcn_fence(__ATOMIC_ACQUIRE, "agent");
            xb_add(&bar[XB_XGEN(b.x)], 1u);
            asm volatile("s_waitcnt vmcnt(0)" ::: "memory");
        } else {
            XB_SPIN(xb_ld(&bar[XB_XGEN(b.x)]) == gen, bar);
            __builtin_amdgcn_fence(__ATOMIC_ACQUIRE, "agent");
            asm volatile("s_waitcnt vmcnt(0)" ::: "memory");
        }
    }
    __syncthreads();
}
constexpr int RSEG = 4, RSEGC = 32;
template <bool PASS3, int VAR = 0>
__device__ __forceinline__ void sweep_pass(char* lds, const bf16* QKV, bf16* Oi, float* LST, const float* lgf, const float* lgb, int vcu, int G) {
    const int tid = threadIdx.x, lane = tid & 63, w = __builtin_amdgcn_readfirstlane(tid >> 6), l15 = lane & 15, quad = lane >> 4;
    constexpr int KSP = 264, VSP = 72, OFF_V = 128 * KSP * 2, OFF_ST = OFF_V + 128 * VSP * 2;
    bf16* Ks = (bf16*)lds;
    bf16* Vs = (bf16*)(lds + OFF_V);
    bf16* St = (bf16*)(lds + OFF_ST);
    const LAS char* Ks3 = (const LAS char*)(LAS unsigned char*)(lds);
    const LAS char* Vs3 = Ks3 + OFF_V;
    const unsigned kbase0 = (unsigned)(uintptr_t)lds + (unsigned)(((8 * quad + (l15 >> 2)) * KSP + 32 * w + 4 * (l15 & 3)) * 2);
    const unsigned vbase0 = (unsigned)(uintptr_t)lds + (unsigned)(OFF_V + ((8 * quad + (l15 >> 2)) * VSP + 4 * (l15 & 3)) * 2);
    for (int unit = vcu; unit < 256; unit += G) {
        const int sl = unit & 7, seg = (unit >> 3) & 3, h = (unit >> 5) & 3, b = unit >> 7;
        const bf16* Qg = QKV + (size_t)(b * 4 + h) * SEQ * 256;
        const bf16* Kg = Qg + (size_t)M * 1024;
        const bf16* Vg = QKV + (size_t)M * 2048 + (size_t)(b * 4 + h) * SEQ * 512 + 64 * sl;
        bf16* Og = Oi + (size_t)b * SEQ * RVW + h * 512 + 64 * sl + 4 * quad;
        for (int dir = 0; dir < 2; ++dir) {
            if (!PASS3 && ((dir == 0 && seg == RSEG - 1) || (dir == 1 && seg == 0))) continue;
            const float lg = dir ? lgb[h] : lgf[h];
            const float l2 = lg * 1.4426950408889634f;
            const float decayC = exp2f(l2 * 128.f);
            float* Lbase = LST + ((size_t)((b * 4 + h) * 2 + dir) * 3) * (256 * 512) + 64 * sl;
            f32x4_t accs[2][4];
#pragma unroll
            for (int mt = 0; mt < 2; ++mt)
#pragma unroll
                for (int nt = 0; nt < 4; ++nt) accs[mt][nt] = (f32x4_t){0.f, 0.f, 0.f, 0.f};
            if (PASS3) {
#pragma unroll
                for (int s2 = 0; s2 < RSEG; ++s2) {
                    const bool use = dir ? (s2 > seg) : (s2 < seg);
                    if (use) {
                        const int dist = dir ? (s2 - seg - 1) : (seg - 1 - s2);
                        const float wgt = exp2f(l2 * 4096.f * (float)dist);
                        const float* Ls = Lbase + (size_t)(dir ? s2 - 1 : s2) * (256 * 512);
#pragma unroll
                        for (int mt = 0; mt < 2; ++mt)
#pragma unroll
                            for (int nt = 0; nt < 4; ++nt)
#pragma unroll
                                for (int j = 0; j < 4; ++j) accs[mt][nt][j] += wgt * Ls[(size_t)(32 * w + 16 * mt + 4 * quad + j) * 512 + 16 * nt + l15];
                    }
                }
            }
            const float qd = exp2f(l2 * (float)(dir ? (128 - (16 * w + l15)) : (16 * w + l15 + 1)));
            float kdr[2];
#pragma unroll
            for (int j = 0; j < 2; ++j) { const int row = (tid + NTHR * j) >> 3; kdr[j] = exp2f(l2 * (float)(dir ? row : (127 - row))); }
            constexpr int NB = PASS3 ? 1 : 2;
            u32x4_t kreg[NB][8], vreg[NB][2]; bf16x8_t qreg[8]; u32x2_t oreg[4];
            const int c0 = seg * RSEGC + (dir ? RSEGC - 1 : 0);
            const unsigned koff = (unsigned)(tid * 8), voff = (unsigned)((tid >> 3) * 512 + (tid & 7) * 8);
            const unsigned qoff = (unsigned)((16 * w + l15) * 256 + 8 * quad), ooff = (unsigned)((16 * w + l15) * RVW);
#define SW_LOAD(c, B) do { const bf16* kc_ = Kg + (size_t)(c) * 128 * 256; const bf16* vc_ = Vg + (size_t)(c) * 128 * 512; \
                _Pragma("unroll") for (int j = 0; j < 8; ++j) kreg[B][j] = *(const u32x4_t*)(kc_ + (size_t)j * 16 * 256 + koff); \
                _Pragma("unroll") for (int j = 0; j < 2; ++j) vreg[B][j] = *(const u32x4_t*)(vc_ + (size_t)j * 64 * 512 + voff); \
            } while (0)
#define SW_LOADQ(c) do { if (PASS3) { const bf16* qc_ = Qg + (size_t)(c) * 128 * 256; \
                _Pragma("unroll") for (int ks = 0; ks < 8; ++ks) qreg[ks] = *(const bf16x8_t*)(qc_ + 32 * ks + qoff); \
                if (dir) { const bf16* oc_ = Og + (size_t)(c) * 128 * RVW; _Pragma("unroll") for (int nt = 0; nt < 4; ++nt) oreg[nt] = *(const u32x2_t*)(oc_ + 16 * nt + ooff); } } \
            } while (0)
            SW_LOAD(c0, 0); if (NB == 2) SW_LOAD(dir ? c0 - 1 : c0 + 1, NB - 1);
#pragma unroll
            for (int i = 0; i < RSEGC; ++i) {
                const int c = dir ? c0 - i : c0 + i;
                if (!(VAR & 8))
#pragma unroll
                for (int j = 0; j < 8; ++j) { const int idx = tid + NTHR * j, row = idx >> 5, c16 = idx & 31; *(u32x4_t*)(Ks + row * KSP + c16 * 8) = kreg[i & (NB - 1)][j]; }
#pragma unroll
                for (int j = 0; j < 2; ++j) { const int idx = tid + NTHR * j, row = idx >> 3, c16 = idx & 7; const u32x4_t k4 = vreg[i & (NB - 1)][j]; const float kk = kdr[j]; u32x4_t o4;
                    o4.x = pk2(bflo(k4.x) * kk, bfhi(k4.x) * kk); o4.y = pk2(bflo(k4.y) * kk, bfhi(k4.y) * kk); o4.z = pk2(bflo(k4.z) * kk, bfhi(k4.z) * kk); o4.w = pk2(bflo(k4.w) * kk, bfhi(k4.w) * kk);
                    *(u32x4_t*)(Vs + row * VSP + c16 * 8) = o4; }
                if (PASS3) {
#pragma unroll
                    for (int mt = 0; mt < 2; ++mt)
#pragma unroll
                        for (int nt = 0; nt < 4; ++nt) { u32x2_t sw; sw.x = pk2(accs[mt][nt].x, accs[mt][nt].y); sw.y = pk2(accs[mt][nt].z, accs[mt][nt].w);
                            *(u32x2_t*)(St + (16 * nt + l15) * KSP + 32 * w + 16 * mt + 4 * quad) = sw; }
                }
                asm volatile("s_waitcnt lgkmcnt(0)" ::: "memory"); __builtin_amdgcn_s_barrier(); asm volatile("" ::: "memory");
                if (!(VAR & 4)) SW_LOADQ(c);
                if (!(VAR & 4) && i + NB < RSEGC) { const int cn = dir ? c - NB : c + NB; SW_LOAD(cn, i & (NB - 1)); }
#pragma unroll
                for (int mt = 0; mt < 2; ++mt)
#pragma unroll
                    for (int nt = 0; nt < 4; ++nt) accs[mt][nt] = accs[mt][nt] * decayC;
                if (!(VAR & 1))
#pragma unroll
                for (int ks = 0; ks < 4; ++ks) {
                    unsigned kb_ = kbase0, vb_ = vbase0; asm volatile("" : "+v"(kb_), "+v"(vb_));
                    const LAS char* kp_ = (const LAS char*)kb_; const LAS char* vp_ = (const LAS char*)vb_;
                    bf16x8_t afr[2], bfr[4];
#pragma unroll
                    for (int mt = 0; mt < 2; ++mt) {
                        const s16x4_t klo = tr_read(kp_ + ((32 * ks) * KSP + 16 * mt) * 2), khi = tr_read(kp_ + ((32 * ks + 4) * KSP + 16 * mt) * 2);
                        afr[mt] = (bf16x8_t){klo[0], klo[1], klo[2], klo[3], khi[0], khi[1], khi[2], khi[3]}; }
#pragma unroll
                    for (int nt = 0; nt < 4; ++nt) {
                        const s16x4_t vlo = tr_read(vp_ + ((32 * ks) * VSP + 16 * nt) * 2), vhi = tr_read(vp_ + ((32 * ks + 4) * VSP + 16 * nt) * 2);
                        bfr[nt] = (bf16x8_t){vlo[0], vlo[1], vlo[2], vlo[3], vhi[0], vhi[1], vhi[2], vhi[3]}; }
#pragma unroll
                    for (int mt = 0; mt < 2; ++mt)
#pragma unroll
                        for (int nt = 0; nt < 4; ++nt) accs[mt][nt] = __builtin_amdgcn_mfma_f32_16x16x32_bf16(afr[mt], bfr[nt], accs[mt][nt], 0, 0, 0);
                }
                if (PASS3 && !(VAR & 2)) {
                    f32x4_t o[4];
#pragma unroll
                    for (int nt = 0; nt < 4; ++nt) o[nt] = (f32x4_t){0.f, 0.f, 0.f, 0.f};
#pragma unroll
                    for (int ks = 0; ks < 8; ++ks)
#pragma unroll
                        for (int nt = 0; nt < 4; ++nt) { const bf16x8_t afr = *(const bf16x8_t*)(St + (16 * nt + l15) * KSP + 32 * ks + 8 * quad); o[nt] = __builtin_amdgcn_mfma_f32_16x16x32_bf16(afr, qreg[ks], o[nt], 0, 0, 0); }
#pragma unroll
                    for (int nt = 0; nt < 4; ++nt) {
                        f32x4_t ov = o[nt] * qd;
                        if (dir) { ov.x += bflo(oreg[nt].x); ov.y += bfhi(oreg[nt].x); ov.z += bflo(oreg[nt].y); ov.w += bfhi(oreg[nt].y); }
                        u32x2_t t; t.x = pk2(ov.x, ov.y); t.y = pk2(ov.z, ov.w);
                        *(u32x2_t*)(Og + (size_t)c * 128 * RVW + 16 * nt + ooff) = t;
                    }
                }
                asm volatile("s_waitcnt lgkmcnt(0)" ::: "memory"); __builtin_amdgcn_s_barrier(); asm volatile("" ::: "memory");
            }
#undef SW_LOAD
#undef SW_LOADQ
            if (!PASS3) {
                float* Ls = Lbase + (size_t)(dir ? seg - 1 : seg) * (256 * 512);
#pragma unroll
                for (int mt = 0; mt < 2; ++mt)
#pragma unroll
                    for (int nt = 0; nt < 4; ++nt)
#pragma unroll
                        for (int j = 0; j < 4; ++j) Ls[(size_t)(32 * w + 16 * mt + 4 * quad + j) * 512 + 16 * nt + l15] = accs[mt][nt][j];
            }
        }
    }
}

__device__ __forceinline__ void intra_phase(char* lds, const bf16* QKV, bf16* Oi, const float* lgf, const float* lgb, const float* gn, int vcu, int G) {
    const int tid = threadIdx.x, lane = tid & 63, w = __builtin_amdgcn_readfirstlane(tid >> 6), l15 = lane & 15, quad = lane >> 4;
    constexpr int VSP = 520, KSP = 264;
    bf16* Vs = (bf16*)lds;
    bf16* Ks = (bf16*)lds;
    const LAS char* Vs3 = (const LAS char*)(LAS unsigned char*)(lds);
    for (int unit = vcu; unit < 1024; unit += G) {
        const int b = unit >> 9, h = (unit >> 7) & 3, c = unit & 127;
        const size_t tokb = (size_t)b * SEQ + (size_t)c * 128;
        const size_t hrow = (size_t)(b * 4 + h) * SEQ + (size_t)c * 128;
        const float l2f = lgf[h] * 1.4426950408889634f, l2b = lgb[h] * 1.4426950408889634f;
        {
            const bf16* ksrc = QKV + (size_t)M * 1024 + hrow * 256;
            const unsigned koff = (unsigned)(tid * 8);
            bf16* kdst = Ks + (tid >> 5) * KSP + (tid & 31) * 8;
            u32x4_t kreg[8];
#pragma unroll
            for (int j = 0; j < 8; ++j) kreg[j] = *(const u32x4_t*)(ksrc + (size_t)j * 16 * 256 + koff);
#pragma unroll
            for (int j = 0; j < 8; ++j) *(u32x4_t*)(kdst + j * 16 * KSP) = kreg[j];
        }
        bf16x8_t qf[8];
#pragma unroll
        for (int ks = 0; ks < 8; ++ks) qf[ks] = *(const bf16x8_t*)(QKV + (hrow + 16 * w + l15) * 256 + 32 * ks + 8 * quad);
        __syncthreads();
        u32x4_t vreg[16];
        {
            const bf16* vsrc = QKV + (size_t)M * 2048 + hrow * 512 + (unsigned)(tid * 8);
#pragma unroll
            for (int j = 0; j < 16; ++j) vreg[j] = *(const u32x4_t*)(vsrc + (size_t)(8 * j) * 512);
        }
        bf16* vdst = Vs + (tid >> 6) * VSP + (tid & 63) * 8;
        __builtin_amdgcn_sched_barrier(0);
        bf16x8_t Bp[4];
        const unsigned kfb0 = (unsigned)(uintptr_t)lds + (unsigned)((l15 * KSP + 8 * quad) * 2);
        int nq = 16 * w + l15; asm volatile("" : "+v"(nq));
#pragma unroll
        for (int a = 0; a < 4; ++a) {
            unsigned pw[4];
#pragma unroll
            for (int e = 0; e < 2; ++e) {
                const int mt = 2 * a + e;
                f32x4_t C = (f32x4_t){0.f, 0.f, 0.f, 0.f};
                unsigned kb_ = kfb0; asm volatile("" : "+v"(kb_)); const LAS char* kp_ = (const LAS char*)kb_;
#pragma unroll
                for (int ks = 0; ks < 8; ++ks) { const bf16x8_t af = *(const LAS bf16x8_t*)(kp_ + ((16 * mt) * KSP + 32 * ks) * 2);
                    C = __builtin_amdgcn_mfma_f32_16x16x32_bf16(af, qf[ks], C, 0, 0, 0); }
                float pv[4];
#pragma unroll
                for (int j = 0; j < 4; ++j) { const int mk = 16 * mt + 4 * quad + j; const int d = nq - mk;
                    const float dec = (d >= 0) ? exp2f(l2f * (float)d) : exp2f(l2b * (float)(-d)); pv[j] = C[j] * dec; }
                pw[2 * e] = pk2(pv[0], pv[1]); pw[2 * e + 1] = pk2(pv[2], pv[3]);
                __builtin_amdgcn_sched_barrier(0);
            }
            Bp[a] = __builtin_bit_cast(bf16x8_t, (u32x4_t){pw[0], pw[1], pw[2], pw[3]});
        }
        __builtin_amdgcn_sched_barrier(0);
        __syncthreads();
#pragma unroll
        for (int j = 0; j < 16; ++j) *(u32x4_t*)(vdst + (8 * j) * VSP) = vreg[j];
        __builtin_amdgcn_sched_barrier(0);
        bf16* orow = Oi + (tokb + 16 * w + l15) * RVW + h * 512 + 4 * quad;
        __syncthreads();
        const int r0b = 4 * quad + (l15 >> 2), cbb = 4 * (l15 & 3);
        const unsigned vbase0 = (unsigned)(uintptr_t)lds + (unsigned)((r0b * VSP + cbb) * 2);
#define PV_TILE(dt, A, OIN) do { A = (f32x4_t){0.f, 0.f, 0.f, 0.f}; unsigned vb_ = vbase0; asm volatile("" : "+v"(vb_)); const LAS char* vp_ = (const LAS char*)vb_; \
            _Pragma("unroll") for (int a = 0; a < 4; ++a) { \
                const s16x4_t lo = tr_read(vp_ + ((32 * a) * VSP + 16 * (dt)) * 2), hi = tr_read(vp_ + ((32 * a + 16) * VSP + 16 * (dt)) * 2); \
                const bf16x8_t af = (bf16x8_t){lo[0], lo[1], lo[2], lo[3], hi[0], hi[1], hi[2], hi[3]}; \
                A = __builtin_amdgcn_mfma_f32_16x16x32_bf16(af, Bp[a], A, 0, 0, 0); } \
            A.x += bflo((OIN).x); A.y += bfhi((OIN).x); A.z += bflo((OIN).y); A.w += bfhi((OIN).y); } while (0)
        float s = 0.f, q = 0.f;
#pragma unroll 1
        for (int hf = 0; hf < 2; ++hf) {
            u32x2_t oin[16];
#pragma unroll
            for (int d2 = 0; d2 < 16; ++d2) oin[d2] = *(const u32x2_t*)(orow + 256 * hf + 16 * d2);
#pragma unroll
            for (int d2 = 0; d2 < 16; ++d2) { f32x4_t A; PV_TILE(16 * hf + d2, A, oin[d2]); s += (A.x + A.y) + (A.z + A.w); q += (A.x * A.x + A.y * A.y) + (A.z * A.z + A.w * A.w); __builtin_amdgcn_sched_barrier(0); }
        }
        s += __shfl_xor(s, 16); s += __shfl_xor(s, 32); q += __shfl_xor(q, 16); q += __shfl_xor(q, 32);
        const float mean = s * (1.f / 512.f);
        const float var = fmaxf(q * (1.f / 512.f) - mean * mean, 0.f);
        const float rstd = 1.f / sqrtf(var + LN_EPS);
        const float* gnp = gn + h * 512 + 4 * quad;
#pragma unroll 1
        for (int hf = 0; hf < 2; ++hf) {
            u32x2_t oin[16];
#pragma unroll
            for (int d2 = 0; d2 < 16; ++d2) oin[d2] = *(const u32x2_t*)(orow + 256 * hf + 16 * d2);
#pragma unroll
            for (int d2 = 0; d2 < 16; ++d2) { f32x4_t A; PV_TILE(16 * hf + d2, A, oin[d2]); const f32x4_t gg = *(const f32x4_t*)(gnp + 256 * hf + 16 * d2); const f32x4_t y = (A - mean) * rstd * gg;
                u32x2_t t; t.x = pk2(y.x, y.y); t.y = pk2(y.z, y.w); *(u32x2_t*)(orow + 256 * hf + 16 * d2) = t; __builtin_amdgcn_sched_barrier(0); }
        }
#undef PV_TILE
        __syncthreads();
    }
}

#ifndef REP0
#define REP0 1
#endif
#ifndef REP1
#define REP1 1
#endif
#ifndef REP2
#define REP2 1
#endif
#ifndef REP3
#define REP3 1
#endif
#ifndef REP4
#define REP4 1
#endif
#ifndef REP5
#define REP5 1
#endif
#ifndef REP6
#define REP6 1
#endif
#ifndef REP7
#define REP7 1
#endif
#ifndef REP8
#define REP8 1
#endif
#ifndef REP9
#define REP9 1
#endif
#ifndef REP10
#define REP10 1
#endif
#ifndef REP11
#define REP11 1
#endif
#ifndef REP12
#define REP12 1
#endif
#ifndef REP13
#define REP13 1
#endif
#ifndef REP14
#define REP14 1
#endif
#ifndef REP15
#define REP15 1
#endif
#ifndef REP16
#define REP16 1
#endif
#ifndef REP17
#define REP17 1
#endif
#ifndef REP18
#define REP18 1
#endif
#ifndef REP19
#define REP19 1
#endif
#ifndef NOP0
#define NOP0 0
#endif
#ifndef NOP1
#define NOP1 0
#endif
#ifndef NOP2
#define NOP2 0
#endif
#ifndef NOP3
#define NOP3 0
#endif
#ifndef NOP4
#define NOP4 0
#endif
#ifndef NOP5
#define NOP5 0
#endif
#ifndef NOP6
#define NOP6 0
#endif
#ifndef NOP7
#define NOP7 0
#endif
#ifndef NOP8
#define NOP8 0
#endif
#ifndef NOP9
#define NOP9 0
#endif
#ifndef NOP10
#define NOP10 0
#endif
#ifndef NOP11
#define NOP11 0
#endif
#ifndef NOP12
#define NOP12 0
#endif
#ifndef NOP13
#define NOP13 0
#endif
#ifndef NOP14
#define NOP14 0
#endif
#ifndef NOP15
#define NOP15 0
#endif
#ifndef NOP16
#define NOP16 0
#endif
#ifndef NOP17
#define NOP17 0
#endif
#ifndef NOP18
#define NOP18 0
#endif
#ifndef NOP19
#define NOP19 0
#endif
__global__ void __launch_bounds__(NTHR, 2) mk_fwd(Args args) {
    extern __shared__ __attribute__((aligned(16))) unsigned char lds[];
    cg::grid_group grid = cg::this_grid();
    const int tid = threadIdx.x, lane = tid & 63, wave = __builtin_amdgcn_readfirstlane(tid >> 6);
    const int G = gridDim.x, bid = blockIdx.x;
    const int vcu = (G % 8 == 0) ? (bid % 8) * (G / 8) + bid / 8 : bid;
    const int gtid = bid * NTHR + tid, gthreads = G * NTHR;
    unsigned char* ws = args.ws;
    const float* x = args.in[0];
    float* out = args.out;
    bf16* W0IN = (bf16*)(ws + WS_W0IN); bf16* W0OUT = (bf16*)(ws + WS_W0OUT); bf16* W0GU = (bf16*)(ws + WS_W0GU); bf16* W0D = (bf16*)(ws + WS_W0D);
    bf16* W1IN = (bf16*)(ws + WS_W1IN); bf16* W1OUT = (bf16*)(ws + WS_W1OUT); bf16* W1GU = (bf16*)(ws + WS_W1GU); bf16* W1D = (bf16*)(ws + WS_W1D);
    float2* tabA = (float2*)(ws + WS_TABA); float2* tabR = (float2*)(ws + WS_TABR);
    bf16* XB = (bf16*)(ws + WS_XB); bf16* AC = (bf16*)(ws + WS_AC); bf16* PROJ0 = (bf16*)(ws + WS_PROJ0);
    float* Y = (float*)(ws + WS_Y); bf16* H = (bf16*)(ws + WS_H); bf16* OI = (bf16*)(ws + WS_OI); bf16* QKV = (bf16*)(ws + WS_QKV); float* Y1 = (float*)(ws + WS_Y1);
    const int lo = args.ph_lo, hi = args.ph_hi;
    volatile LAS unsigned* xb_st = (volatile LAS unsigned*)((LAS unsigned char*)lds + 147440);
    if (tid < 2) xb_st[tid] = 0u;
    __syncthreads();
    XcdBarrier xbar = xcd_barrier_post((unsigned*)(ws + WS_BAR), xb_st);
#define IN(k) (lo <= (k) && (k) < hi)
#define SEAM(k) do { if (IN(k) && IN((k) + 1)) { if ((k) == 0) grid.sync(); else xcd_barrier(xbar); } } while (0)
#define GEMM_RUN(EPI, Aptr, Bptr, Nn, Kk, ...) do { pg8::Gemm g{(const pg8::bf16_t*)(Aptr), (const pg8::bf16_t*)(Bptr), M, (Nn), (Kk)}; pg8::StaticOrder S; S.init(M, (Nn), G, bid); \
        pg8::EPI E{__VA_ARGS__}; pg8::gemm_phase<pg8::EPI, pg8::StaticOrder, true, true>((LAS unsigned char*)lds, g, S, E); } while (0)

    if (IN(0) && !NOP0) {
        LAS float* scr = (LAS float*)((LAS unsigned char*)lds + wave * 16384);
        const int gw = bid * NWAVES + wave, NGW = G * NWAVES;
        constexpr int I0 = 16 * (L0N / 32), I1 = 16 * 32, I2 = 16 * (FFH / 32), I3 = (FFH / 64) * 32, I4 = 16 * (6144 / 32), I5 = 32 * 32;
        constexpr int NITEMS = I0 + I1 + 2 * I2 + I3 + I4 + I5 + 2 * I2 + I3;
        for (int it = gw; it < NITEMS; it += NGW) {
            int r = it;
            if (r < I0) { p0_transpose_item(args.in[1], 1024, L0N, W0IN, 0, scr, r, lane); continue; } r -= I0;
            if (r < I1) { p0_transpose_item(args.in[8], 1024, 1024, W0OUT, 0, scr, r, lane); continue; } r -= I1;
            if (r < I2) { p0_transpose_item(args.in[11], 1024, FFH, W0GU, 1, scr, r, lane); continue; } r -= I2;
            if (r < I2) { p0_transpose_item(args.in[12], 1024, FFH, W0GU, 2, scr, r, lane); continue; } r -= I2;
            if (r < I3) { p0_transpose_item(args.in[13], FFH, 1024, W0D, 0, scr, r, lane); continue; } r -= I3;
            if (r < I4) { p0_transpose_item(args.in[16], 1024, 6144, W1IN, 0, scr, r, lane); continue; } r -= I4;
            if (r < I5) { p0_transpose_item(args.in[20], 2048, 1024, W1OUT, 0, scr, r, lane); continue; } r -= I5;
            if (r < I2) { p0_transpose_item(args.in[23], 1024, FFH, W1GU, 1, scr, r, lane); continue; } r -= I2;
            if (r < I2) { p0_transpose_item(args.in[24], 1024, FFH, W1GU, 2, scr, r, lane); continue; } r -= I2;
            p0_transpose_item(args.in[25], FFH, 1024, W1D, 0, scr, r, lane);
        }
        for (int i = gtid; i < M * DMODEL / 8; i += gthreads) {
            const f32x4_t a = ((const f32x4_t*)x)[2 * i], b = ((const f32x4_t*)x)[2 * i + 1];
            u32x4_t w; w.x = pk2(a.x, a.y); w.y = pk2(a.z, a.w); w.z = pk2(b.x, b.y); w.w = pk2(b.z, b.w);
            ((u32x4_t*)XB)[i] = w;
        }
        if (gtid < 256 * 16) { const int pos = gtid >> 4, j = gtid & 15; const float f = powf(10000.0f, -(float)(2 * j) / 32.0f); const float ang = (float)pos * f;
            tabA[gtid] = make_float2((float)cos((double)ang), (float)sin((double)ang)); }
        else if (gtid < 256 * 16 + 256 * 64) { const int k = gtid - 256 * 16, pos = k >> 6, j = k & 63; const float f = powf(10000.0f, -(float)(2 * j) / 128.0f); const float ang = (float)pos * f;
            tabR[k] = make_float2((float)cos((double)ang), (float)sin((double)ang)); }
    }
    SEAM(0);
    if (IN(1) && !NOP1) for (int rep_ = 0; rep_ < REP1; ++rep_) GEMM_RUN(EpiBf16, XB, W0IN, L0N, 1024, (pg8::bf16_t*)PROJ0, L0N);
    SEAM(1);
    if (IN(2) && !NOP2) {
        qk_norm_rope(PROJ0, args.in[2], args.in[3], tabA, gtid, gthreads);
        for (int rep_ = 0; rep_ < REP2; ++rep_) conv_phase((char*)lds, PROJ0, args.in[4], args.in[5], args.in[6], args.in[7], AC, bid, G);
    }
    SEAM(2);
    if (IN(3) && !NOP3) {
        for (int rep_ = 0; rep_ < REP3; ++rep_) for (int u = bid; u < 1024; u += G) {
            const int bkv = u >> 8, r = u & 255, b = bkv >> 1, kvh = bkv & 1, hq = kvh * 4 + (r >> 6), qb = r & 63;
            attn_body::attn_unit<8>(b, hq, kvh, qb, (const attn_body::bf16*)PROJ0, (const attn_body::bf16*)(PROJ0 + 512), (const attn_body::bf16*)(PROJ0 + 640), (attn_body::bf16*)AC, (char*)lds);
        }
    }
    SEAM(3);
    if (IN(4) && !NOP4) for (int rep_ = 0; rep_ < REP4; ++rep_) GEMM_RUN(EpiResF32, AC, W0OUT, 1024, 1024, x, Y, 1024, ALPHA);
    SEAM(4);
    if (IN(5) && !NOP5) for (int rep_ = 0; rep_ < REP5; ++rep_) ln_phase(Y, args.in[9], args.in[10], out, XB, bid, G, wave, lane);
    SEAM(5);
    if (IN(6) && !NOP6) for (int rep_ = 0; rep_ < REP6; ++rep_) GEMM_RUN(EpiGateUp, XB, W0GU, 2 * FFH, 1024, (pg8::bf16_t*)H, FFH);
    SEAM(6);
    if (IN(7) && !NOP7) for (int rep_ = 0; rep_ < REP7; ++rep_) GEMM_RUN(EpiResF32, H, W0D, 1024, FFH, out, Y, 1024, ALPHA);
    SEAM(7);
    if (IN(8) && !NOP8) for (int rep_ = 0; rep_ < REP8; ++rep_) ln_phase(Y, args.in[14], args.in[15], out, XB, bid, G, wave, lane);
    SEAM(8);
    if (IN(9) && !NOP9) GEMM_RUN(EpiQKV1, XB, W1IN, L1QKV, 1024, (pg8::bf16_t*)QKV, (pg8::bf16_t*)(QKV + (size_t)M * 1024), (pg8::bf16_t*)(QKV + (size_t)M * 2048), (const float*)tabR);
    SEAM(9);
    if (IN(11) && !NOP11) sweep_pass<false>((char*)lds, QKV, OI, (float*)ws, args.in[17], args.in[18], vcu, G);
    SEAM(11);
    if (IN(12) && !NOP12) sweep_pass<true>((char*)lds, QKV, OI, (float*)ws, args.in[17], args.in[18], vcu, G);
    SEAM(12);
#ifdef PROBE_LIST
    if (lo >= 20) {
        if (lo == 25) qk_norm_rope(PROJ0, args.in[2], args.in[3], tabA, gtid, gthreads);
        if (lo == 26) conv_phase((char*)lds, PROJ0, args.in[4], args.in[5], args.in[6], args.in[7], AC, bid, G);
        if (lo == 20) sweep_pass<true, 1>((char*)lds, QKV, OI, (float*)ws, args.in[17], args.in[18], vcu, G);
        if (lo == 21) sweep_pass<true, 2>((char*)lds, QKV, OI, (float*)ws, args.in[17], args.in[18], vcu, G);
        if (lo == 22) sweep_pass<true, 4>((char*)lds, QKV, OI, (float*)ws, args.in[17], args.in[18], vcu, G);
        if (lo == 23) sweep_pass<true, 8>((char*)lds, QKV, OI, (float*)ws, args.in[17], args.in[18], vcu, G);
        if (lo == 24) sweep_pass<true, 3>((char*)lds, QKV, OI, (float*)ws, args.in[17], args.in[18], vcu, G);
    }
#endif
    if (IN(13) && !NOP13) intra_phase((char*)lds, QKV, OI, args.in[17], args.in[18], args.in[19], vcu, G);
    SEAM(13);
    if (IN(14) && !NOP14) for (int rep_ = 0; rep_ < REP14; ++rep_) GEMM_RUN(EpiGateMul, XB, W1IN + (size_t)4096 * 1024, RVW, 1024, (pg8::bf16_t*)OI, RVW);
    SEAM(14);
    if (IN(15) && !NOP15) for (int rep_ = 0; rep_ < REP15; ++rep_) GEMM_RUN(EpiResF32, OI, W1OUT, 1024, RVW, out, Y1, 1024, ALPHA);
    SEAM(15);
    if (IN(16) && !NOP16) for (int rep_ = 0; rep_ < REP16; ++rep_) ln_phase(Y1, args.in[21], args.in[22], out, XB, bid, G, wave, lane);
    SEAM(16);
    if (IN(17) && !NOP17) for (int rep_ = 0; rep_ < REP17; ++rep_) GEMM_RUN(EpiGateUp, XB, W1GU, 2 * FFH, 1024, (pg8::bf16_t*)H, FFH);
    SEAM(17);
    if (IN(18) && !NOP18) for (int rep_ = 0; rep_ < REP18; ++rep_) GEMM_RUN(EpiResF32, H, W1D, 1024, FFH, out, Y, 1024, ALPHA);
    SEAM(18);
    if (IN(19) && !NOP19) for (int rep_ = 0; rep_ < REP19; ++rep_) ln_phase(Y, args.in[26], args.in[27], out, nullptr, bid, G, wave, lane);
#undef IN
#undef SEAM
#undef GEMM_RUN
}

#ifndef MK_ONE_LAUNCH
#define MK_ONE_LAUNCH 1
#endif
extern "C" void kernel_launch(void* const* d_in, const int* in_sizes, int n_in, void* d_out, int out_size, void* d_ws, size_t ws_size, hipStream_t stream) {
    static int grid = 0;
    if (grid == 0) {
        if (n_in != 28 || out_size != M * DMODEL || ws_size < WS_NEED) { fprintf(stderr, "kernel_launch: unexpected sizes: n_in %d out %d ws %zu\n", n_in, out_size, ws_size); grid = -1; return; }
        int dev = 0, cus = 0, per_cu = 0;
        hipGetDevice(&dev); hipDeviceGetAttribute(&cus, hipDeviceAttributeMultiprocessorCount, dev);
        hipFuncSetAttribute((const void*)mk_fwd, hipFuncAttributeMaxDynamicSharedMemorySize, LDS_BYTES);
        hipOccupancyMaxActiveBlocksPerMultiprocessor(&per_cu, (const void*)mk_fwd, NTHR, LDS_BYTES);
        if (per_cu < 1) { fprintf(stderr, "kernel_launch: occupancy query says %d blocks per CU\n", per_cu); per_cu = 1; }
        (void)hipGetLastError();
        grid = cus * per_cu;
    }
    if (grid < 0) return;
    Args a{};
    for (int i = 0; i < 28; ++i) a.in[i] = (const float*)d_in[i];
    a.out = (float*)d_out; a.ws = (unsigned char*)d_ws;
#if MK_ONE_LAUNCH
    a.ph_lo = 0; a.ph_hi = 20;
    (void)hipMemsetAsync((char*)d_ws + WS_BAR, 0, 16384, stream);
    void* kargs[] = {&a};
    hipError_t e = hipLaunchCooperativeKernel((const void*)mk_fwd, dim3(grid), dim3(NTHR), kargs, LDS_BYTES, stream);
    if (e != hipSuccess) fprintf(stderr, "cooperative launch failed: %s (grid %d)\n", hipGetErrorString(e), grid);
#ifdef PROBE_LIST
    { const int plist[] = PROBE_LIST; for (int p : plist) { a.ph_lo = p; a.ph_hi = p + 1; hipLaunchKernelGGL(mk_fwd, dim3(grid), dim3(NTHR), LDS_BYTES, stream, a); } }
#endif
#else
    for (int p = 0; p < 20; ++p) { a.ph_lo = p; a.ph_hi = p + 1; hipLaunchKernelGGL(mk_fwd, dim3(grid), dim3(NTHR), LDS_BYTES, stream, a); }
#endif
}
```

```cpp
#include <hip/hip_runtime.h>
#include <hip/hip_cooperative_groups.h>
#include <hip/hip_bf16.h>
#include <cstdio>
#include <cstdint>
#include <cmath>
namespace cg = cooperative_groups;

namespace pg8 {
#define PG8_LAS __attribute__((address_space(3)))
typedef unsigned short bf16_t;
typedef short bf16x8 __attribute__((ext_vector_type(8)));
typedef float f32x4 __attribute__((ext_vector_type(4)));
typedef unsigned u32x4 __attribute__((ext_vector_type(4)));
constexpr int BM = 256, BK = 64, HALF = 128, HTB = HALF * BK * 2  , STAGE_BYTES = 8 * HTB, NXCD = 8, WGM = 8;

__host__ __device__ __forceinline__ int lds_byte(int r, int c) { const int st = (r >> 4) * 2 + (c >> 5), rr = r & 15, cc = c & 31, ob = rr * 64 + cc * 2; return st * 1024 + (ob ^ (((ob >> 9) & 1) << 5)); }
__host__ __device__ __forceinline__ void stage_rc(int b, int& R, int& C) { const int st = b / 1024, sb = b % 1024, swz = sb ^ (((sb >> 9) & 1) << 5); R = (st >> 1) * 16 + swz / 64; C = (st & 1) * 32 + (swz % 64) / 2; }
__host__ __device__ __forceinline__ int perm32(int rho) { const int n = rho >> 4, i = rho & 15; return 8 * (i >> 2) + 4 * n + (i & 3); }

struct Unit { int pm, pn; };
struct Gemm { const bf16_t* A; const bf16_t* Bt; int M, N, K; };

struct StaticOrder {
    int nM, nN, nwg, G, c;
    __host__ __device__ void init(int M, int N, int G_, int c_) { nM = M / BM; nN = N / BM; nwg = nM * nN; G = G_; c = c_; }
    __host__ __device__ bool next(int i, Unit& u) const {
        const long L = (long)i * G + c; if (L >= nwg) return false;
        int wgid = (int)L; { const int q = nwg / NXCD, r = nwg % NXCD, xcd = wgid % NXCD, off = wgid / NXCD; wgid = (xcd < r ? xcd * (q + 1) : r * (q + 1) + (xcd - r) * q) + off; }
        const int nig = WGM * nN, gid = wgid / nig, fm = gid * WGM, gsz = (nM - fm) < WGM ? (nM - fm) : WGM;
        u.pm = fm + ((wgid % nig) % gsz); u.pn = (wgid % nig) / gsz; return true;
    }
    __device__ __forceinline__ void a_ready(const Unit&) const {}
    __device__ __forceinline__ void done(const Unit&) const {}
};

__device__ __forceinline__ unsigned cvt_pk_bf16(float lo, float hi) { unsigned r; asm volatile("v_cvt_pk_bf16_f32 %0, %1, %2" : "=v"(r) : "v"(lo), "v"(hi)); return r; }
typedef float f32x2 __attribute__((ext_vector_type(2)));
__device__ __forceinline__ float silu_f(float v) { return v * __builtin_amdgcn_rcpf(1.0f + __builtin_amdgcn_exp2f(v * -1.4426950408889634f)); }
__device__ __forceinline__ float bf_lo(unsigned w) { return __uint_as_float(w << 16); }
__device__ __forceinline__ float bf_hi(unsigned w) { return __uint_as_float(w & 0xffff0000u); }
struct EpiBf16 {
    static constexpr bool PERM = true, AFTER_DRAIN = false;
    bf16_t* O; int ldc;
    __device__ __forceinline__ void operator()(const f32x4 (&acc)[2][2][4][2], const Unit& u, int wr, int wc, int fr, int fq) const {
        const int row0 = u.pm * BM + wr * 64 + fr; const int col0 = u.pn * BM + wc * 32 + 8 * fq;
#pragma unroll
        for (int ai = 0; ai < 2; ++ai)
#pragma unroll
            for (int m = 0; m < 4; ++m) { bf16_t* rowp = O + (size_t)(row0 + ai * HALF + m * 16) * ldc + col0;
#pragma unroll
                for (int bj = 0; bj < 2; ++bj) { const f32x4 v0 = acc[ai][bj][m][0], v1 = acc[ai][bj][m][1];
                    u32x4 w; w.x = cvt_pk_bf16(v0[0], v0[1]); w.y = cvt_pk_bf16(v0[2], v0[3]); w.z = cvt_pk_bf16(v1[0], v1[1]); w.w = cvt_pk_bf16(v1[2], v1[3]);
                    *(u32x4*)(rowp + bj * HALF) = w; } }
    }
};
struct EpiGateUp {
    static constexpr bool PERM = true, AFTER_DRAIN = false;
    bf16_t* O; int ldc;
    __device__ __forceinline__ void operator()(const f32x4 (&acc)[2][2][4][2], const Unit& u, int wr, int wc, int fr, int fq) const {
        const int row0 = u.pm * BM + wr * 64 + fr; const int col0 = u.pn * HALF + wc * 32 + 8 * fq;
#pragma unroll
        for (int ai = 0; ai < 2; ++ai)
#pragma unroll
            for (int m = 0; m < 4; ++m) { bf16_t* rowp = O + (size_t)(row0 + ai * HALF + m * 16) * ldc + col0;
                const f32x4 g0 = acc[ai][0][m][0], g1 = acc[ai][0][m][1], u0 = acc[ai][1][m][0], u1 = acc[ai][1][m][1];
                u32x4 w;
                w.x = cvt_pk_bf16(silu_f(g0[0]) * u0[0], silu_f(g0[1]) * u0[1]); w.y = cvt_pk_bf16(silu_f(g0[2]) * u0[2], silu_f(g0[3]) * u0[3]);
                w.z = cvt_pk_bf16(silu_f(g1[0]) * u1[0], silu_f(g1[1]) * u1[1]); w.w = cvt_pk_bf16(silu_f(g1[2]) * u1[2], silu_f(g1[3]) * u1[3]);
                *(u32x4*)rowp = w; }
    }
};
struct EpiResF32 {
    static constexpr bool PERM = false, AFTER_DRAIN = false;
    const float* res; float* out; int ldc; float alpha;
    __device__ __forceinline__ void operator()(const f32x4 (&acc)[2][2][4][2], const Unit& u, int wr, int wc, int fr, int fq) const {
        const int col0 = u.pn * BM + wc * 32 + 4 * fq;
#pragma unroll
        for (int ai = 0; ai < 2; ++ai)
#pragma unroll
            for (int m = 0; m < 4; ++m) { const size_t off = (size_t)(u.pm * BM + ai * HALF + wr * 64 + m * 16 + fr) * ldc + col0;
#pragma unroll
                for (int bj = 0; bj < 2; ++bj)
#pragma unroll
                    for (int n = 0; n < 2; ++n) { const f32x4 r4 = *(const f32x4*)(res + off + bj * HALF + n * 16);
                        *(f32x4*)(out + off + bj * HALF + n * 16) = r4 * alpha + acc[ai][bj][m][n]; } }
    }
};
struct EpiGateMul {
    static constexpr bool PERM = true, AFTER_DRAIN = false;
    bf16_t* O; int ldc;
    __device__ __forceinline__ void operator()(const f32x4 (&acc)[2][2][4][2], const Unit& u, int wr, int wc, int fr, int fq) const {
        const int row0 = u.pm * BM + wr * 64 + fr; const int col0 = u.pn * BM + wc * 32 + 8 * fq;
#pragma unroll
        for (int ai = 0; ai < 2; ++ai)
#pragma unroll
            for (int m = 0; m < 4; ++m) { bf16_t* rowp = O + (size_t)(row0 + ai * HALF + m * 16) * ldc + col0;
#pragma unroll
                for (int bj = 0; bj < 2; ++bj) { const f32x4 v0 = acc[ai][bj][m][0], v1 = acc[ai][bj][m][1];
                    const u32x4 y = *(const u32x4*)(rowp + bj * HALF); u32x4 w;
                    w.x = cvt_pk_bf16(silu_f(v0[0]) * bf_lo(y.x), silu_f(v0[1]) * bf_hi(y.x)); w.y = cvt_pk_bf16(silu_f(v0[2]) * bf_lo(y.y), silu_f(v0[3]) * bf_hi(y.y));
                    w.z = cvt_pk_bf16(silu_f(v1[0]) * bf_lo(y.z), silu_f(v1[1]) * bf_hi(y.z)); w.w = cvt_pk_bf16(silu_f(v1[2]) * bf_lo(y.w), silu_f(v1[3]) * bf_hi(y.w));
                    *(u32x4*)(rowp + bj * HALF) = w; } }
    }
};

struct EpiQKV1 {
    static constexpr bool PERM = true, AFTER_DRAIN = false;
    bf16_t* Qh; bf16_t* Kh; bf16_t* Vh; const float* tab;
    __device__ __forceinline__ void operator()(const f32x4 (&acc)[2][2][4][2], const Unit& u, int wr, int wc, int fr, int fq) const {
        constexpr int S_ = 16384;
        const int b = u.pm >> 6;
        if (u.pn < 8) {
            const int h = u.pn & 3; bf16_t* base = (u.pn < 4 ? Qh : Kh) + (size_t)(3 * b + h) * S_ * 256;
            const float sc = (u.pn < 4) ? 1.0f : 0.0625f;
            const int idx = wc * 32 + 8 * fq;
#pragma unroll
            for (int ai = 0; ai < 2; ++ai)
#pragma unroll
                for (int m = 0; m < 4; ++m) {
                    const int r = u.pm * BM + ai * HALF + wr * 64 + m * 16 + fr, s = r & (S_ - 1);
                    const int pos = (wc < 2) ? (s >> 6) : (s & 63);
                    const f32x4* tp = (const f32x4*)(tab + ((size_t)pos * 64 + (idx & 63)) * 2);
                    const f32x4 t0 = tp[0], t1 = tp[1], t2 = tp[2], t3 = tp[3];
                    const f32x4 a0 = acc[ai][0][m][0], a1 = acc[ai][0][m][1], b0 = acc[ai][1][m][0], b1 = acc[ai][1][m][1];
                    u32x4 w1, w2;
                    w1.x = cvt_pk_bf16((a0[0] * t0[0] - b0[0] * t0[1]) * sc, (a0[1] * t0[2] - b0[1] * t0[3]) * sc);
                    w1.y = cvt_pk_bf16((a0[2] * t1[0] - b0[2] * t1[1]) * sc, (a0[3] * t1[2] - b0[3] * t1[3]) * sc);
                    w1.z = cvt_pk_bf16((a1[0] * t2[0] - b1[0] * t2[1]) * sc, (a1[1] * t2[2] - b1[1] * t2[3]) * sc);
                    w1.w = cvt_pk_bf16((a1[2] * t3[0] - b1[2] * t3[1]) * sc, (a1[3] * t3[2] - b1[3] * t3[3]) * sc);
                    w2.x = cvt_pk_bf16((a0[0] * t0[1] + b0[0] * t0[0]) * sc, (a0[1] * t0[3] + b0[1] * t0[2]) * sc);
                    w2.y = cvt_pk_bf16((a0[2] * t1[1] + b0[2] * t1[0]) * sc, (a0[3] * t1[3] + b0[3] * t1[2]) * sc);
                    w2.z = cvt_pk_bf16((a1[0] * t2[1] + b1[0] * t2[0]) * sc, (a1[1] * t2[3] + b1[1] * t2[2]) * sc);
                    w2.w = cvt_pk_bf16((a1[2] * t3[1] + b1[2] * t3[0]) * sc, (a1[3] * t3[3] + b1[3] * t3[2]) * sc);
                    bf16_t* rowp = base + (size_t)r * 256 + idx;
                    *(u32x4*)rowp = w1; *(u32x4*)(rowp + 128) = w2;
                }
        } else {
            const int hv = (u.pn - 8) >> 1, hf = (u.pn - 8) & 1; bf16_t* base = Vh + (size_t)(3 * b + hv) * S_ * 512 + hf * 256 + wc * 32 + 8 * fq;
#pragma unroll
            for (int ai = 0; ai < 2; ++ai)
#pragma unroll
                for (int m = 0; m < 4; ++m) { bf16_t* rowp = base + (size_t)(u.pm * BM + ai * HALF + wr * 64 + m * 16 + fr) * 512;
#pragma unroll
                    for (int bj = 0; bj < 2; ++bj) { const f32x4 v0 = acc[ai][bj][m][0], v1 = acc[ai][bj][m][1];
                        u32x4 w; w.x = cvt_pk_bf16(v0[0], v0[1]); w.y = cvt_pk_bf16(v0[2], v0[3]); w.z = cvt_pk_bf16(v1[0], v1[1]); w.w = cvt_pk_bf16(v1[2], v1[3]);
                        *(u32x4*)(rowp + bj * HALF) = w; } }
        }
    }
};

struct EpiResBf16 {
    static constexpr bool PERM = false, AFTER_DRAIN = false;
    const bf16_t* res; float* out; int ldc; float alpha;
    __device__ __forceinline__ void operator()(const f32x4 (&acc)[2][2][4][2], const Unit& u, int wr, int wc, int fr, int fq) const {
        typedef unsigned u32x2 __attribute__((ext_vector_type(2)));
        const int col0 = u.pn * BM + wc * 32 + 4 * fq;
#pragma unroll
        for (int ai = 0; ai < 2; ++ai)
#pragma unroll
            for (int m = 0; m < 4; ++m) { const size_t off = (size_t)(u.pm * BM + ai * HALF + wr * 64 + m * 16 + fr) * ldc + col0;
#pragma unroll
                for (int bj = 0; bj < 2; ++bj)
#pragma unroll
                    for (int n = 0; n < 2; ++n) { const u32x2 r2 = *(const u32x2*)(res + off + bj * HALF + n * 16);
                        const f32x4 r4 = (f32x4){bf_lo(r2.x), bf_hi(r2.x), bf_lo(r2.y), bf_hi(r2.y)};
                        *(f32x4*)(out + off + bj * HALF + n * 16) = r4 * alpha + acc[ai][bj][m][n]; } }
    }
};

template <class Epi, class Sched, bool ALIGN_EPI = false, bool SP2 = false>
__device__ __forceinline__ void gemm_phase(PG8_LAS unsigned char* lds, const Gemm g, const Sched& S, const Epi& E) {
    const int tid = threadIdx.x, wid = __builtin_amdgcn_readfirstlane(tid >> 6), lane = tid & 63, wr = wid >> 2, wc = wid & 3, fr = lane & 15, fq = lane >> 4;
    const int K = g.K, nt = K / BK;
    unsigned voffA[2], voffB[2];
#pragma unroll
    for (int i = 0; i < 2; ++i) { int R, C; stage_rc(tid * 16 + i * 8192, R, C); const int Rb = Epi::PERM ? ((R & ~31) + perm32(R & 31)) : R;
        voffA[i] = (unsigned)(R * K + C) * 2u; voffB[i] = (unsigned)(Rb * K + C) * 2u; }
    const size_t kstep = (size_t)(BK * 2);
    const size_t hstep = (size_t)HALF * K * 2;
    const size_t tstep = 2 * hstep;
    const unsigned ldsw = (unsigned)wid * 1024u;
    const int aoff = lds_byte(wr * 64 + fr, fq * 8), boff = lds_byte(wc * 32 + fr, fq * 8);
#define PG8_SA(b, h) (((b) * 2 + (h)) * HTB)
#define PG8_SB(b, h) ((4 + (b) * 2 + (h)) * HTB)
#define PG8_STAGE(bufoff, gbase, voff) do { _Pragma("unroll") for (int _i = 0; _i < 2; ++_i) \
        __builtin_amdgcn_global_load_lds((const unsigned*)((const char*)(gbase) + (voff)[_i]), (PG8_LAS unsigned*)(lds + (bufoff) + ldsw + _i * 8192), 16, 0, 0); } while (0)
#define PG8_LDA(dst, b, h) do { _Pragma("unroll") for (int m = 0; m < 4; ++m) _Pragma("unroll") for (int k = 0; k < 2; ++k) dst[m][k] = *(const PG8_LAS bf16x8*)(lds + PG8_SA(b, h) + aoff + m * 2048 + k * 1024); } while (0)
#define PG8_LDB(dst, b, h) do { _Pragma("unroll") for (int n = 0; n < 2; ++n) _Pragma("unroll") for (int k = 0; k < 2; ++k) dst[n][k] = *(const PG8_LAS bf16x8*)(lds + PG8_SB(b, h) + boff + n * 2048 + k * 1024); } while (0)
#define PG8_MMA(ai, bj, At, Bt) do { __builtin_amdgcn_s_setprio(1); _Pragma("unroll") for (int m = 0; m < 4; ++m) _Pragma("unroll") for (int n = 0; n < 2; ++n) _Pragma("unroll") for (int k = 0; k < 2; ++k) \
        acc[ai][bj][m][n] = __builtin_amdgcn_mfma_f32_16x16x32_bf16(Bt[n][k], At[m][k], acc[ai][bj][m][n], 0, 0, 0); __builtin_amdgcn_s_setprio(0); } while (0)
#define PG8_WAIT_V(n) asm volatile("s_waitcnt vmcnt(" #n ")" ::: "memory")
#define PG8_WAIT_L(n) asm volatile("s_waitcnt lgkmcnt(" #n ")" ::: "memory")
#define PG8_BAR __builtin_amdgcn_s_barrier()
#define PG8_SCHED __builtin_amdgcn_sched_barrier(0)
    Unit cur, nxt; int ui = 0;
    if (!S.next(0, cur)) return;
    f32x4 acc[2][2][4][2];
#pragma unroll
    for (int a = 0; a < 2; ++a)
#pragma unroll
        for (int b = 0; b < 2; ++b)
#pragma unroll
            for (int m = 0; m < 4; ++m)
#pragma unroll
                for (int n = 0; n < 2; ++n) acc[a][b][m][n] = (f32x4){0.f, 0.f, 0.f, 0.f};
    bf16x8 At[4][2], B0[2][2], B1[2][2];
    const char* cA = (const char*)g.A + (size_t)cur.pm * tstep; const char* cB = (const char*)g.Bt + (size_t)cur.pn * tstep;
    S.a_ready(cur);
    if constexpr (SP2) {
        PG8_STAGE(PG8_SB(0, 0), cB, voffB); PG8_STAGE(PG8_SB(0, 1), cB + hstep, voffB); PG8_STAGE(PG8_SA(0, 0), cA, voffA); PG8_STAGE(PG8_SA(0, 1), cA + hstep, voffA);
        if (wr == 1) PG8_BAR;
        PG8_WAIT_V(2); PG8_BAR;
        PG8_STAGE(PG8_SB(1, 0), cB + kstep, voffB); PG8_STAGE(PG8_SA(1, 0), cA + kstep, voffA); PG8_STAGE(PG8_SB(1, 1), cB + hstep + kstep, voffB);
        PG8_WAIT_V(6); PG8_BAR;
    } else {
        PG8_STAGE(PG8_SB(0, 0), cB, voffB); PG8_STAGE(PG8_SA(0, 0), cA, voffA); PG8_STAGE(PG8_SB(0, 1), cB + hstep, voffB); PG8_STAGE(PG8_SA(0, 1), cA + hstep, voffA);
        if (wr == 1) PG8_BAR;
        PG8_WAIT_V(4); PG8_BAR;
        PG8_STAGE(PG8_SB(1, 0), cB + kstep, voffB); PG8_STAGE(PG8_SA(1, 0), cA + kstep, voffA); PG8_STAGE(PG8_SB(1, 1), cB + hstep + kstep, voffB);
        PG8_WAIT_V(6); PG8_BAR;
    }
    for (;;) {
        const bool has_next = S.next(ui + 1, nxt);
        const char* nA = has_next ? (const char*)g.A + (size_t)nxt.pm * tstep : cA; const char* nB = has_next ? (const char*)g.Bt + (size_t)nxt.pn * tstep : cB;
        for (int t = 0; t < nt; t += 2) {
            const bool last = (t == nt - 2);
            const char* a1 = cA + (size_t)(t + 1) * kstep;
            const char* a2 = last ? nA : cA + (size_t)(t + 2) * kstep; const char* b2 = last ? nB : cB + (size_t)(t + 2) * kstep;
            const char* a3 = a2 + kstep; const char* b3 = b2 + kstep;
            if (last && has_next) S.a_ready(nxt);
            if constexpr (SP2) {
            PG8_LDB(B0, 0, 0); PG8_LDB(B1, 0, 1); PG8_SCHED; PG8_LDA(At, 0, 0); PG8_STAGE(PG8_SA(1, 1), a1 + hstep, voffA);
            PG8_WAIT_V(8); PG8_WAIT_L(0); PG8_BAR; PG8_MMA(0, 0, At, B0); PG8_MMA(0, 1, At, B1); PG8_BAR; PG8_SCHED;
            PG8_LDA(At, 0, 1); PG8_STAGE(PG8_SB(0, 0), b2, voffB); PG8_STAGE(PG8_SB(0, 1), b2 + hstep, voffB); PG8_STAGE(PG8_SA(0, 0), a2, voffA);
            PG8_WAIT_V(8); PG8_WAIT_L(0); PG8_BAR; PG8_MMA(1, 0, At, B0); PG8_MMA(1, 1, At, B1); PG8_BAR; PG8_SCHED;
            PG8_LDB(B0, 1, 0); PG8_LDB(B1, 1, 1); PG8_SCHED; PG8_LDA(At, 1, 0); PG8_STAGE(PG8_SA(0, 1), a2 + hstep, voffA);
            PG8_WAIT_V(8); PG8_WAIT_L(0); PG8_BAR; PG8_MMA(0, 0, At, B0); PG8_MMA(0, 1, At, B1); PG8_BAR; PG8_SCHED;
            PG8_LDA(At, 1, 1); PG8_STAGE(PG8_SB(1, 0), b3, voffB); PG8_STAGE(PG8_SB(1, 1), b3 + hstep, voffB); PG8_STAGE(PG8_SA(1, 0), a3, voffA);
            PG8_WAIT_V(8); PG8_WAIT_L(0); PG8_BAR; PG8_MMA(1, 0, At, B0); PG8_MMA(1, 1, At, B1); PG8_BAR; PG8_SCHED;
            } else {
            PG8_LDB(B0, 0, 0); PG8_SCHED; PG8_LDA(At, 0, 0); PG8_STAGE(PG8_SA(1, 1), a1 + hstep, voffA);
            PG8_WAIT_L(8); PG8_BAR; PG8_WAIT_L(0); PG8_MMA(0, 0, At, B0); PG8_BAR; PG8_SCHED;
            PG8_LDB(B1, 0, 1); PG8_STAGE(PG8_SB(0, 0), b2, voffB);
            PG8_BAR; PG8_WAIT_L(0); PG8_MMA(0, 1, At, B1); PG8_BAR;
            PG8_LDA(At, 0, 1); PG8_STAGE(PG8_SA(0, 0), a2, voffA);
            PG8_BAR; PG8_WAIT_L(0); PG8_MMA(1, 0, At, B0); PG8_BAR; PG8_SCHED;
            PG8_STAGE(PG8_SB(0, 1), b2 + hstep, voffB);
            PG8_WAIT_V(6); PG8_BAR; PG8_MMA(1, 1, At, B1); PG8_BAR;
            PG8_LDB(B0, 1, 0); PG8_SCHED; PG8_LDA(At, 1, 0); PG8_STAGE(PG8_SA(0, 1), a2 + hstep, voffA);
            PG8_WAIT_L(8); PG8_BAR; PG8_WAIT_L(0); PG8_MMA(0, 0, At, B0); PG8_BAR; PG8_SCHED;
            PG8_LDB(B1, 1, 1); PG8_STAGE(PG8_SB(1, 0), b3, voffB);
            PG8_BAR; PG8_WAIT_L(0); PG8_MMA(0, 1, At, B1); PG8_BAR;
            PG8_LDA(At, 1, 1); PG8_STAGE(PG8_SA(1, 0), a3, voffA);
            PG8_BAR; PG8_WAIT_L(0); PG8_MMA(1, 0, At, B0); PG8_BAR; PG8_SCHED;
            PG8_STAGE(PG8_SB(1, 1), b3 + hstep, voffB);
            PG8_WAIT_V(6); PG8_BAR; PG8_MMA(1, 1, At, B1); PG8_BAR;
            }
        }
        if constexpr (ALIGN_EPI) { if (wr == 0) PG8_BAR; }
        if constexpr (!Epi::AFTER_DRAIN) { E(acc, cur, wr, wc, fr, fq); S.done(cur); }
        if (!has_next) break;
#pragma unroll
        for (int a = 0; a < 2; ++a)
#pragma unroll
            for (int b = 0; b < 2; ++b)
#pragma unroll
                for (int m = 0; m < 4; ++m)
#pragma unroll
                    for (int n = 0; n < 2; ++n) acc[a][b][m][n] = (f32x4){0.f, 0.f, 0.f, 0.f};
        cur = nxt; cA = nA; cB = nB; ++ui;
        if constexpr (ALIGN_EPI) { if (wr == 1) PG8_BAR; }
    }
    PG8_WAIT_V(0);
    if constexpr (!ALIGN_EPI) { if (wr == 0) PG8_BAR; }
    PG8_BAR;
    if constexpr (Epi::AFTER_DRAIN) { E.fused(acc, cur, wr, wc, fr, fq, lds, wid, lane); S.done(cur); }
#undef PG8_SA
#undef PG8_SB
#undef PG8_STAGE
#undef PG8_LDA
#undef PG8_LDB
#undef PG8_MMA
#undef PG8_WAIT_V
#undef PG8_WAIT_L
#undef PG8_BAR
#undef PG8_SCHED
}
}
#include <hip/hip_bf16.h>
#include <cmath>
namespace attn_body {
using bf16=__hip_bfloat16;
using bf16x8=__attribute__((ext_vector_type(8)))short;
using s16x4=__attribute__((ext_vector_type(4)))short;
using f32x16=__attribute__((ext_vector_type(16)))float;
using u32x4=__attribute__((ext_vector_type(4)))unsigned;
constexpr int BATCH=2,NHEAD=8,SEQ=16384,D=64,QP=1792,KP=1792,OP=1024;
constexpr int NW=8,QBLK=32,QB=QBLK*NW,KVBLK=64,NQB=SEQ/QB;
constexpr int ATTN_UNIT_ROWS=QB;
__device__ __forceinline__ int crow(int r,int hi){return (r&3)+8*(r>>2)+4*hi;}
#define SBAR() __builtin_amdgcn_sched_barrier(0)
__device__ __forceinline__ void cmask(f32x16&p0,f32x16&p1,int jb,int qrel,int hi){
  const float NEG=-INFINITY; int kb=64*jb+4*hi;
  #pragma unroll
  for(int r=0;r<16;++r){int kv=kb+(r&3)+8*(r>>2); if(kv>qrel)p0[r]=NEG; if(kv+32>qrel)p1[r]=NEG;}
}

constexpr int NSLOT=3, SLOTB=8192;
constexpr int LDS_K=0, LDS_V=NSLOT*SLOTB, LDS_WS=2*NSLOT*SLOTB, LDS_OST=LDS_WS+NW*64*4, LDS_BYTES=LDS_OST+NW*4096;
constexpr float C2=0.125f*1.4426950408889634f;
__device__ __forceinline__ void glds16(const void*gsrc,unsigned lds_dst){unsigned keep;
  asm volatile("s_mov_b32 %0, m0\n\ts_mov_b32 m0, %2\n\ts_nop 0\n\tglobal_load_lds_dwordx4 %1, off\n\ts_mov_b32 m0, %0":"=&s"(keep):"v"(gsrc),"s"(lds_dst):"memory");}
__device__ __forceinline__ float max3f(float a,float b,float c){float r;asm("v_max3_f32 %0, %1, %2, %3":"=v"(r):"v"(a),"v"(b),"v"(c));return r;}
__device__ __forceinline__ float max2f(float a,float b){float r;asm("v_max_f32_e32 %0, %1, %2":"=v"(r):"v"(a),"v"(b));return r;}
__device__ __forceinline__ float fadd_s(float a,float b){float r;asm("v_add_f32_e32 %0, %1, %2":"=v"(r):"v"(a),"v"(b));return r;}
__device__ __forceinline__ float fsub_s(float a,float b){float r;asm("v_sub_f32_e32 %0, %1, %2":"=v"(r):"v"(a),"v"(b));return r;}
typedef float f32x2_t __attribute__((ext_vector_type(2))); typedef __bf16 bf16x2_t __attribute__((ext_vector_type(2)));
__device__ __forceinline__ unsigned cvtpk_s(float lo,float hi){f32x2_t v={lo,hi};bf16x2_t b=__builtin_convertvector(v,bf16x2_t);return __builtin_bit_cast(unsigned,b);}
#define WAIT_BAR(N) asm volatile("s_waitcnt vmcnt(" #N ") lgkmcnt(0)\n\ts_barrier":::"memory")

__device__ __forceinline__ void qkt(f32x16&p0,f32x16&p1,const char*Kslot,const bf16x8*qr,const f32x16&negm,int r32,int hi){
  const char*kb=Kslot+hi*1024+r32*16;
  #pragma unroll
  for(int d0=0;d0<4;++d0){
    const bf16x8 b0=*reinterpret_cast<const bf16x8*>(kb+d0*2048);
    const bf16x8 b1=*reinterpret_cast<const bf16x8*>(kb+d0*2048+512);
    if(d0==0){p0=__builtin_amdgcn_mfma_f32_32x32x16_bf16(b0,qr[0],negm,0,0,0);p1=__builtin_amdgcn_mfma_f32_32x32x16_bf16(b1,qr[0],negm,0,0,0);}
    else{p0=__builtin_amdgcn_mfma_f32_32x32x16_bf16(b0,qr[d0],p0,0,0,0);p1=__builtin_amdgcn_mfma_f32_32x32x16_bf16(b1,qr[d0],p1,0,0,0);}}
}
typedef __attribute__((address_space(3))) const char* lds_cptr;
typedef short v4i16_t __attribute__((ext_vector_type(4)));
__device__ __forceinline__ void kload8(bf16x8*kf,lds_cptr kp){
  kf[0]=*(const __attribute__((address_space(3))) bf16x8*)(kp);      kf[1]=*(const __attribute__((address_space(3))) bf16x8*)(kp+512);
  kf[2]=*(const __attribute__((address_space(3))) bf16x8*)(kp+2048); kf[3]=*(const __attribute__((address_space(3))) bf16x8*)(kp+2560);
  kf[4]=*(const __attribute__((address_space(3))) bf16x8*)(kp+4096); kf[5]=*(const __attribute__((address_space(3))) bf16x8*)(kp+4608);
  kf[6]=*(const __attribute__((address_space(3))) bf16x8*)(kp+6144); kf[7]=*(const __attribute__((address_space(3))) bf16x8*)(kp+6656);
}
__device__ __forceinline__ void kload2(bf16x8*kf,lds_cptr kp,int j){ kf[2*j]=*(const __attribute__((address_space(3))) bf16x8*)(kp+j*2048); kf[2*j+1]=*(const __attribute__((address_space(3))) bf16x8*)(kp+j*2048+512); }
__device__ __forceinline__ s16x4 vtr(lds_cptr p){ return __builtin_bit_cast(s16x4,__builtin_amdgcn_ds_read_tr16_b64_v4i16((__attribute__((address_space(3))) v4i16_t*)p)); }
__device__ __forceinline__ float rowmax(const f32x16&p0,const f32x16&p1){
  float a=max3f(p0[0],p0[1],p1[0]),b=max3f(p0[2],p0[3],p1[1]);a=max3f(a,p1[2],p1[3]);
  #pragma unroll
  for(int r=4;r<16;r+=4){a=max3f(a,p0[r],p0[r+1]);b=max3f(b,p0[r+2],p0[r+3]);a=max3f(a,p1[r],p1[r+1]);b=max3f(b,p1[r+2],p1[r+3]);}
  const float m=max2f(a,b);
  auto rr=__builtin_amdgcn_permlane32_swap(__float_as_uint(m),__float_as_uint(m),false,false);
  return max2f(__uint_as_float(rr[0]),__uint_as_float(rr[1]));
}
__device__ __forceinline__ void pv(f32x16*o,int vb,bf16x8 pa0,bf16x8 pa1,bf16x8 pa2,bf16x8 pa3){
  #pragma unroll
  for(int d0=0;d0<2;++d0){s16x4 lo[4],hi[4];
    #pragma unroll
    for(int ks=0;ks<4;++ks){
      asm volatile("ds_read_b64_tr_b16 %0,%1 offset:%c2":"=&v"(lo[ks]):"v"(vb),"i"(d0*4096+ks*1024):"memory");
      asm volatile("ds_read_b64_tr_b16 %0,%1 offset:%c2":"=&v"(hi[ks]):"v"(vb),"i"(d0*4096+ks*1024+512):"memory");}
    asm volatile("s_waitcnt lgkmcnt(0)":::"memory");SBAR();
    #define PK(k) (bf16x8){lo[k][0],lo[k][1],lo[k][2],lo[k][3],hi[k][0],hi[k][1],hi[k][2],hi[k][3]}
    o[d0]=__builtin_amdgcn_mfma_f32_32x32x16_bf16(pa0,PK(0),o[d0],0,0,0);
    o[d0]=__builtin_amdgcn_mfma_f32_32x32x16_bf16(pa1,PK(1),o[d0],0,0,0);
    o[d0]=__builtin_amdgcn_mfma_f32_32x32x16_bf16(pa2,PK(2),o[d0],0,0,0);
    o[d0]=__builtin_amdgcn_mfma_f32_32x32x16_bf16(pa3,PK(3),o[d0],0,0,0);
    #undef PK
  }
}

#ifndef ATTN_STORE16
#define ATTN_STORE16(p,v) (*(u32x4*)(p)=(v))
#endif
template<int THRL> __device__ __forceinline__ void attn_unit(int b,int h,int kvh,int qb,const bf16*Q,const bf16*__restrict__ K,const bf16*__restrict__ V,bf16*O,char*shm){
  const int tid=threadIdx.x,lane=tid&63,r32=lane&31,hi=lane>>5; const int wid=__builtin_amdgcn_readfirstlane(tid>>6);
  const long rowbase=(long)b*SEQ; const int q0=qb*QB;
  const bf16*Qw=Q+(rowbase+q0+wid*QBLK)*QP+h*D;
  const bf16*Kh=K+rowbase*KP+kvh*D,*Vh=V+rowbase*KP+kvh*D;
  const unsigned lds0=(unsigned)(uintptr_t)shm;
  float*wsf=(float*)(shm+LDS_WS)+wid*64;
  const bf16*ksrc=Kh+(long)lane*KP+wid*8;
  const bf16*vsrc=Vh+(long)(16*(wid&3)+(lane>>2))*KP+(wid>>2)*32+(lane&3)*8;
  const unsigned kdst=lds0+LDS_K+wid*1024, vdst=lds0+LDS_V+wid*1024;
  #define DMA_K(t,slot) glds16(ksrc+(long)(t)*KVBLK*KP,(unsigned)__builtin_amdgcn_readfirstlane(kdst+(slot)))
  #define DMA_V(t,slot) glds16(vsrc+(long)(t)*KVBLK*KP,(unsigned)__builtin_amdgcn_readfirstlane(vdst+(slot)))
  const int vb0=(int)(lds0+LDS_V)+((lane>>4)&1)*32+(lane&3)*8+(4*hi+((lane&15)>>2))*64;
  const char*Kbase=shm+LDS_K; bf16x8 kf[8];
  const lds_cptr shm3=(lds_cptr)shm; const lds_cptr kp0=shm3+LDS_K+hi*1024+r32*16; const lds_cptr vp0=shm3+LDS_V+((lane>>4)&1)*32+(lane&3)*8+(4*hi+((lane&15)>>2))*64;
  const int NT=SEQ/KVBLK;
  DMA_K(0,0);DMA_V(0,0);DMA_K(1,SLOTB);
  bf16x8 qr[4];
  #pragma unroll
  for(int d0=0;d0<4;++d0)qr[d0]=*reinterpret_cast<const bf16x8*>(&Qw[(long)r32*QP+d0*16+hi*8]);
  float mhat=0.f,l_reg=0.f;f32x16 o[2];o[0]=f32x16{};o[1]=f32x16{};f32x16 negm=f32x16{};asm volatile("":"+v"(negm));
  const int qrel=wid*QBLK+r32;
  #define CMASK(P0,P1,t) do{}while(0)
  bool resc=false;
  #define START(P0,P1) do{ const float rm=rowmax(P0,P1); resc=false; \
    { const float dl=rm; mhat=fadd_s(mhat,dl); \
      _Pragma("unroll") for(int r=0;r<16;++r){P0[r]=fsub_s(P0[r],dl);P1[r]=fsub_s(P1[r],dl);} \
      _Pragma("unroll") for(int r=0;r<16;++r)negm[r]=-mhat; asm volatile("":"+v"(negm)); } \
    _Pragma("unroll") for(int r=0;r<16;++r)P0[r]=__builtin_amdgcn_exp2f(P0[r]); }while(0)
  #define RESC() do{ if(resc){ asm volatile("s_waitcnt lgkmcnt(0)":::"memory"); \
      _Pragma("unroll") for(int d_=0;d_<2;++d_) _Pragma("unroll") for(int r=0;r<16;++r)o[d_][r]*=wsf[crow(r,hi)]; } }while(0)
  f32x16 pA0,pA1,pB0,pB1;
  int sl_prev=0,sl_cur=0,sl_next=SLOTB;
  #define ROT() do{sl_prev=sl_cur;sl_cur=sl_next;sl_next=(sl_next==(NSLOT-1)*SLOTB)?0:sl_next+SLOTB;}while(0)
  DMA_K(2,2*SLOTB);
  WAIT_BAR(3);
  qkt(pA0,pA1,Kbase,qr,negm,r32,hi);asm volatile("s_nop 15\n\ts_nop 7":"+v"(pA0),"+v"(pA1));CMASK(pA0,pA1,0);
  START(pA0,pA1);
  _Pragma("unroll") for(int r=0;r<16;++r)pA1[r]=__builtin_amdgcn_exp2f(pA1[r]);
  WAIT_BAR(0);
  DMA_K(3,0);DMA_V(1,SLOTB);
  ROT();
  kload8(kf,kp0+sl_cur);
  WAIT_BAR(2);
  s16x4 vlo[8],vhi[8]; u32x4 pw0,pw1,pw2,pw3;
  #define PKW(P,B) cvtpk_s(P[B],P[B+1])
  #define PAF(k) __builtin_bit_cast(bf16x8,pw##k)
  #define VFR(i) (bf16x8){vlo[i][0],vlo[i][1],vlo[i][2],vlo[i][3],vhi[i][0],vhi[i][1],vhi[i][2],vhi[i][3]}
  #define PIN(x) asm volatile("":"+v"(x))
  #define MX3(a,b,c) __builtin_fmaxf(__builtin_fmaxf((a),(b)),(c))
  #define GAPA(MF,A0,A1,A2,A3,W0,W1,PW) do{ MF; sacc+=A0; sacc+=A1; sacc+=A2; sacc+=A3; PIN(sacc); W0; W1; PIN(PW); SBAR(); }while(0)
  #define EX(v) __builtin_amdgcn_exp2f(v)
  #define GAPB(MF,X,B) do{ MF; X[B]=EX(X[B]); X[B+1]=EX(X[B+1]); X[B+2]=EX(X[B+2]); X[B+3]=EX(X[B+3]); PIN(X); SBAR(); }while(0)
  #define VRD(i) do{ vlo[i]=vtr(vp_+(((i)>>2)*4096+((i)&3)*1024)); vhi[i]=vtr(vp_+(((i)>>2)*4096+((i)&3)*1024+512)); }while(0)
  #define KRD(G,j) do{ if(G){ kload2(kf,kp0+sl_next,j); SBAR(); } }while(0)
  #define STEP(C0,C1,P0,P1,t,GK,GV,GL) do{ SBAR(); \
    const lds_cptr vp_=vp0+sl_prev; \
    VRD(0); SBAR(); float sacc=(P0[0]+P0[1]); \
    GAPA(C0=__builtin_amdgcn_mfma_f32_32x32x16_bf16(kf[0],qr[0],negm,0,0,0), P0[2],P0[3],P0[4],P0[5],     pw0[0]=PKW(P0,0), pw0[1]=PKW(P0,2), pw0); \
    VRD(4); SBAR(); GAPA(C1=__builtin_amdgcn_mfma_f32_32x32x16_bf16(kf[1],qr[0],negm,0,0,0), P0[6],P0[7],P0[8],P0[9],     pw0[2]=PKW(P0,4), pw0[3]=PKW(P0,6), pw0); \
    VRD(1); SBAR(); GAPA(C0=__builtin_amdgcn_mfma_f32_32x32x16_bf16(kf[2],qr[1],C0,0,0,0),   P0[10],P0[11],P0[12],P0[13], pw1[0]=PKW(P0,8), pw1[1]=PKW(P0,10), pw1); \
    VRD(5); SBAR(); GAPA(C1=__builtin_amdgcn_mfma_f32_32x32x16_bf16(kf[3],qr[1],C1,0,0,0),   P0[14],P0[15],P1[0],P1[1],   pw1[2]=PKW(P0,12),pw1[3]=PKW(P0,14), pw1); \
    VRD(2); SBAR(); GAPA(C0=__builtin_amdgcn_mfma_f32_32x32x16_bf16(kf[4],qr[2],C0,0,0,0),   P1[2],P1[3],P1[4],P1[5],     pw2[0]=PKW(P1,0), pw2[1]=PKW(P1,2), pw2); \
    VRD(6); SBAR(); GAPA(C1=__builtin_amdgcn_mfma_f32_32x32x16_bf16(kf[5],qr[2],C1,0,0,0),   P1[6],P1[7],P1[8],P1[9],     pw2[2]=PKW(P1,4), pw2[3]=PKW(P1,6), pw2); \
    VRD(3); SBAR(); GAPA(C0=__builtin_amdgcn_mfma_f32_32x32x16_bf16(kf[6],qr[3],C0,0,0,0),   P1[10],P1[11],P1[12],P1[13], pw3[0]=PKW(P1,8), pw3[1]=PKW(P1,10), pw3); \
    VRD(7); SBAR(); GAPA(C1=__builtin_amdgcn_mfma_f32_32x32x16_bf16(kf[7],qr[3],C1,0,0,0),   P1[14],P1[15],0.f,0.f,       pw3[2]=PKW(P1,12),pw3[3]=PKW(P1,14), pw3); \
    l_reg+=sacc; \
    if(GK){DMA_K((t)+3,sl_cur);} if(GV){DMA_V((t)+1,sl_next);} \
    CMASK(C0,C1,t); \
    { float a=MX3(C0[0],C0[1],C1[0]),b=MX3(C0[2],C0[3],C1[1]); a=MX3(a,C1[2],C1[3]); \
      _Pragma("unroll") for(int r=4;r<16;r+=4){a=MX3(a,C0[r],C0[r+1]);b=MX3(b,C0[r+2],C0[r+3]);a=MX3(a,C1[r],C1[r+1]);b=MX3(b,C1[r+2],C1[r+3]);} \
      float rm=__builtin_fmaxf(a,b); { auto rr=__builtin_amdgcn_permlane32_swap(__float_as_uint(rm),__float_as_uint(rm),false,false); rm=__builtin_fmaxf(__uint_as_float(rr[0]),__uint_as_float(rr[1])); } \
      resc=false; \
      if(__builtin_expect(__any(rm>(float)THRL),0)){ const float dl=__builtin_fmaxf(rm,0.f); mhat+=dl; \
        _Pragma("unroll") for(int r=0;r<16;++r){C0[r]-=dl;C1[r]-=dl;} \
        _Pragma("unroll") for(int r=0;r<16;++r)negm[r]=-mhat; asm volatile("":"+v"(negm)); \
        const float f=__builtin_amdgcn_exp2f(-dl); l_reg*=f; if(hi==0)wsf[r32]=f; resc=true; } } \
    SBAR(); \
    GAPB(o[0]=__builtin_amdgcn_mfma_f32_32x32x16_bf16(PAF(0),VFR(0),o[0],0,0,0), C0,0); \
    GAPB(o[1]=__builtin_amdgcn_mfma_f32_32x32x16_bf16(PAF(0),VFR(4),o[1],0,0,0), C0,4); \
    KRD(GL,0); GAPB(o[0]=__builtin_amdgcn_mfma_f32_32x32x16_bf16(PAF(1),VFR(1),o[0],0,0,0), C0,8); \
    KRD(GL,1); GAPB(o[1]=__builtin_amdgcn_mfma_f32_32x32x16_bf16(PAF(1),VFR(5),o[1],0,0,0), C0,12); \
    KRD(GL,2); GAPB(o[0]=__builtin_amdgcn_mfma_f32_32x32x16_bf16(PAF(2),VFR(2),o[0],0,0,0), C1,0); \
    KRD(GL,3); GAPB(o[1]=__builtin_amdgcn_mfma_f32_32x32x16_bf16(PAF(2),VFR(6),o[1],0,0,0), C1,4); \
    GAPB(o[0]=__builtin_amdgcn_mfma_f32_32x32x16_bf16(PAF(3),VFR(3),o[0],0,0,0), C1,8); \
    GAPB(o[1]=__builtin_amdgcn_mfma_f32_32x32x16_bf16(PAF(3),VFR(7),o[1],0,0,0), C1,12); \
    }while(0)
  int t=1;
  #undef CMASK
  #define CMASK(P0,P1,t) do{}while(0)
  for(;t+5<NT;t+=2){
    STEP(pB0,pB1,pA0,pA1,t,true,true,true);     WAIT_BAR(2); RESC(); ROT();
    STEP(pA0,pA1,pB0,pB1,t+1,true,true,true);   WAIT_BAR(2); RESC(); ROT();
  }
  #undef CMASK
  #define CMASK(P0,P1,t) do{}while(0)
  #define ENDW(tt) do{ if((tt)+3<NT){WAIT_BAR(2);} else if((tt)+2<NT){WAIT_BAR(1);} else {WAIT_BAR(0);} }while(0)
  for(;t+1<NT;t+=2){
    STEP(pB0,pB1,pA0,pA1,t,(t+3<NT),(t+1<NT),(t+1<NT));       ENDW(t);   RESC(); ROT();
    STEP(pA0,pA1,pB0,pB1,t+1,(t+4<NT),(t+2<NT),(t+2<NT));     ENDW(t+1); RESC(); ROT();
  }
  STEP(pB0,pB1,pA0,pA1,NT-1,false,false,false); RESC();
  { float sacc=pB0[0]+pB0[1]; _Pragma("unroll") for(int r=2;r<16;++r)sacc+=pB0[r]; _Pragma("unroll") for(int r=0;r<16;++r)sacc+=pB1[r]; l_reg+=sacc;
    pw0=(u32x4){PKW(pB0,0),PKW(pB0,2),PKW(pB0,4),PKW(pB0,6)};pw1=(u32x4){PKW(pB0,8),PKW(pB0,10),PKW(pB0,12),PKW(pB0,14)};pw2=(u32x4){PKW(pB1,0),PKW(pB1,2),PKW(pB1,4),PKW(pB1,6)};pw3=(u32x4){PKW(pB1,8),PKW(pB1,10),PKW(pB1,12),PKW(pB1,14)};
    SBAR(); pv(o,vb0+sl_cur,PAF(0),PAF(1),PAF(2),PAF(3)); }
  #undef PKW
  #undef PAF
  #undef VFR
  #undef PIN
  #undef MX3
  #undef GAPA
  #undef GAPB
  #undef EX
  #undef VRD
  #undef KRD
  #undef STEP
  #undef ENDW
  {auto rr=__builtin_amdgcn_permlane32_swap(__float_as_uint(l_reg),__float_as_uint(l_reg),false,false);l_reg=__uint_as_float(rr[0])+__uint_as_float(rr[1]);}
  if(hi==0)wsf[32+r32]=l_reg;asm volatile("s_waitcnt lgkmcnt(0)":::"memory");
  float rli[16];
  #pragma unroll
  for(int r=0;r<16;++r)rli[r]=__builtin_amdgcn_rcpf(wsf[32+crow(r,hi)]);
  bf16*Ow=O+(rowbase+q0+wid*QBLK)*OP+h*D;
  { bf16*stg=(bf16*)(shm+LDS_OST)+wid*2048;
    #pragma unroll
    for(int r=0;r<16;++r){const int orow=crow(r,hi);
      #pragma unroll
      for(int d0=0;d0<2;++d0)stg[orow*64+d0*32+r32]=__float2bfloat16(o[d0][r]*rli[r]);}
    asm volatile("s_waitcnt lgkmcnt(0)":::"memory");
    #pragma unroll
    for(int i=0;i<4;++i){const int row=i*8+(lane>>3),ch=lane&7; const u32x4 v=*(const u32x4*)(stg+row*64+ch*8); ATTN_STORE16(Ow+(long)row*OP+ch*8,v);} }
  asm volatile("s_waitcnt lgkmcnt(0)\n\ts_barrier":::"memory");
  #undef DMA_K
  #undef DMA_V
  #undef CMASK
  #undef START
  #undef RESC
  #undef ROT
}
constexpr int ATTN_LDS_BYTES=LDS_BYTES;
#undef SBAR
#undef WAIT_BAR
}
#define LAS __attribute__((address_space(3)))
typedef unsigned short bf16;
typedef unsigned u32x4_t __attribute__((ext_vector_type(4)));
typedef unsigned u32x2_t __attribute__((ext_vector_type(2)));
typedef float f32x4_t __attribute__((ext_vector_type(4)));
typedef short bf16x8_t __attribute__((ext_vector_type(8)));
typedef short s16x4_t __attribute__((ext_vector_type(4)));

constexpr int NWAVES = 8, NTHR = 512;
constexpr int BATCH = 2, SEQ = 16384, DMODEL = 1024, M = BATCH * SEQ;
constexpr int L0N = 1792, FFH = 2816, L1QKV = 4096, RVW = 2048;
constexpr float ALPHA = 1.4142135623730951f;
constexpr float LN_EPS = 1e-5f, RMS_EPS = 1e-6f;
constexpr int LDS_BYTES = 147456;
constexpr size_t MiB = 1u << 20;
constexpr size_t WS_W0IN = 0, WS_W0OUT = 4 * MiB, WS_W0GU = 6 * MiB, WS_W0D = 17 * MiB, WS_W1IN = 23 * MiB, WS_W1OUT = 35 * MiB, WS_W1GU = 39 * MiB, WS_W1D = 50 * MiB;
constexpr size_t WS_TABA = 56 * MiB, WS_TABR = 57 * MiB, WS_BAR = 58 * MiB;
constexpr size_t WS_XB = 64 * MiB;
constexpr size_t WS_AC = 128 * MiB;
constexpr size_t WS_PROJ0 = 192 * MiB;
constexpr size_t WS_Y = 320 * MiB;
constexpr size_t WS_H = 128 * MiB;
constexpr size_t WS_OI = 128 * MiB;
constexpr size_t WS_QKV = 256 * MiB;
constexpr size_t WS_Y1 = 256 * MiB;
constexpr size_t WS_NEED = 512 * MiB;

__device__ __forceinline__ unsigned f2bf(float f) { unsigned u = __builtin_bit_cast(unsigned, f); return (u + 0x7fffu + ((u >> 16) & 1u)) >> 16; }
typedef float f32x2_cv __attribute__((ext_vector_type(2))); typedef __bf16 bf16x2_cv __attribute__((ext_vector_type(2)));
__device__ __forceinline__ unsigned pk2(float lo, float hi) { f32x2_cv v = {lo, hi}; bf16x2_cv b = __builtin_convertvector(v, bf16x2_cv); return __builtin_bit_cast(unsigned, b); }
__device__ __forceinline__ float bflo(unsigned w) { return __uint_as_float(w << 16); }
__device__ __forceinline__ float bfhi(unsigned w) { return __uint_as_float(w & 0xffff0000u); }
__device__ __forceinline__ float bf2f(unsigned short h) { return __uint_as_float(((unsigned)h) << 16); }
__device__ __forceinline__ float wave_sum(float v) {
#pragma unroll
    for (int o = 1; o < 64; o <<= 1) v += __shfl_xor(v, o);
    return v;
}
__device__ __forceinline__ float sigmoid_f(float v) { return __builtin_amdgcn_rcpf(1.0f + __builtin_amdgcn_exp2f(v * -1.4426950408889634f)); }
__device__ __forceinline__ s16x4_t tr_read(const LAS void* p) {
    typedef short v4i16_t __attribute__((ext_vector_type(4)));
    return __builtin_bit_cast(s16x4_t, __builtin_amdgcn_ds_read_tr16_b64_v4i16((LAS v4i16_t*)p));
}

__device__ __forceinline__ void p0_transpose_item(const float* W, int K, int N, bf16* WT, int mode, LAS float* scr, int item, int lane) {
    const int nblk = N / 32, kb = item / nblk, nb = item % nblk, k0 = 64 * kb, n0 = 32 * nb;
    const int r0 = (mode == 0) ? n0 : (256 * (n0 / 128) + (n0 % 128) + (mode == 2 ? 128 : 0));
#pragma unroll 8
    for (int i = 0; i < 32; ++i) { const int kk = 2 * i + (lane >> 5); scr[kk * 33 + (lane & 31)] = W[(size_t)(k0 + kk) * N + n0 + (lane & 31)]; }
    asm volatile("s_waitcnt lgkmcnt(0)" ::: "memory");
    const int c = lane & 7;
#pragma unroll
    for (int j = 0; j < 4; ++j) { const int n = (lane >> 3) + 8 * j; const LAS float* s = scr + (8 * c) * 33 + n;
        u32x4_t o; o.x = pk2(s[0 * 33], s[1 * 33]); o.y = pk2(s[2 * 33], s[3 * 33]); o.z = pk2(s[4 * 33], s[5 * 33]); o.w = pk2(s[6 * 33], s[7 * 33]);
        *(u32x4_t*)(WT + (size_t)(r0 + n) * K + k0 + 8 * c) = o; }
    asm volatile("s_waitcnt lgkmcnt(0)" ::: "memory");
}

struct Args { const float* in[28]; float* out; unsigned char* ws; int ph_lo, ph_hi; };

__device__ __forceinline__ void ln_row(const float* yrow, const float* g, const float* bta, float* of, bf16* ob, int lane) {
    const f32x4_t* xr = (const f32x4_t*)yrow + lane;
    f32x4_t v[4]; float s = 0.f;
#pragma unroll
    for (int j = 0; j < 4; ++j) { v[j] = xr[64 * j]; s += (v[j].x + v[j].y) + (v[j].z + v[j].w); }
    const float mean = wave_sum(s) * (1.f / DMODEL); float s2 = 0.f;
#pragma unroll
    for (int j = 0; j < 4; ++j) { v[j] = v[j] - mean; s2 += (v[j].x * v[j].x + v[j].y * v[j].y) + (v[j].z * v[j].z + v[j].w * v[j].w); }
    const float rstd = 1.f / sqrtf(wave_sum(s2) * (1.f / DMODEL) + LN_EPS);
#pragma unroll
    for (int j = 0; j < 4; ++j) {
        const f32x4_t gg = ((const f32x4_t*)g)[lane + 64 * j], bb = ((const f32x4_t*)bta)[lane + 64 * j];
        const f32x4_t o = v[j] * rstd * gg + bb;
        if (of) ((f32x4_t*)of)[lane + 64 * j] = o;
        if (ob) { u32x2_t w; w.x = pk2(o.x, o.y); w.y = pk2(o.z, o.w); ((u32x2_t*)ob)[lane + 64 * j] = w; }
    }
}
__device__ __forceinline__ void ln_phase(const float* Y, const float* g, const float* b, float* of, bf16* ob, int bid, int G, int wave, int lane) {
    const int NW = G * NWAVES, gw = bid * NWAVES + wave;
    f32x4_t gg[4], bb[4];
#pragma unroll
    for (int j = 0; j < 4; ++j) { gg[j] = ((const f32x4_t*)g)[lane + 64 * j]; bb[j] = ((const f32x4_t*)b)[lane + 64 * j]; }
    for (int m0 = gw; m0 < M; m0 += 4 * NW) {
        f32x4_t v[4][4]; float s[4];
#pragma unroll
        for (int r = 0; r < 4; ++r) { const f32x4_t* xr = (const f32x4_t*)(Y + (size_t)(m0 + r * NW) * DMODEL) + lane;
#pragma unroll
            for (int j = 0; j < 4; ++j) v[r][j] = xr[64 * j]; }
#pragma unroll
        for (int r = 0; r < 4; ++r) { float t = 0.f;
#pragma unroll
            for (int j = 0; j < 4; ++j) t += (v[r][j].x + v[r][j].y) + (v[r][j].z + v[r][j].w);
            s[r] = t; }
#pragma unroll
        for (int o = 1; o < 64; o <<= 1) {
#pragma unroll
            for (int r = 0; r < 4; ++r) s[r] += __shfl_xor(s[r], o); }
        float q[4];
#pragma unroll
        for (int r = 0; r < 4; ++r) { const float mean = s[r] * (1.f / DMODEL); float t = 0.f;
#pragma unroll
            for (int j = 0; j < 4; ++j) { v[r][j] = v[r][j] - mean; t += (v[r][j].x * v[r][j].x + v[r][j].y * v[r][j].y) + (v[r][j].z * v[r][j].z + v[r][j].w * v[r][j].w); }
            q[r] = t; }
#pragma unroll
        for (int o = 1; o < 64; o <<= 1) {
#pragma unroll
            for (int r = 0; r < 4; ++r) q[r] += __shfl_xor(q[r], o); }
#pragma unroll
        for (int r = 0; r < 4; ++r) { const float rstd = 1.f / sqrtf(q[r] * (1.f / DMODEL) + LN_EPS); const size_t ro = (size_t)(m0 + r * NW) * DMODEL;
#pragma unroll
            for (int j = 0; j < 4; ++j) { const f32x4_t o = v[r][j] * rstd * gg[j] + bb[j];
                if (of) ((f32x4_t*)(of + ro))[lane + 64 * j] = o;
                if (ob) { u32x2_t w; w.x = pk2(o.x, o.y); w.y = pk2(o.z, o.w); ((u32x2_t*)(ob + ro))[lane + 64 * j] = w; } } }
    }
}

__device__ __forceinline__ void qk_norm_rope(bf16* P0, const float* qg, const float* kg, const float2* tabA, int gtid, int gthreads) {
    const int sub = gtid & 7, s3 = sub & 3, ngrp = gthreads >> 3;
    for (int it0 = gtid >> 3; it0 < M * 10; it0 += 4 * ngrp) {
        u32x4_t wv[4];
#pragma unroll
        for (int u = 0; u < 4; ++u) { const int it = it0 + u * ngrp, tok = it / 10, hh = it - tok * 10; wv[u] = *(const u32x4_t*)(P0 + (size_t)tok * L0N + hh * 64 + 8 * sub); }
#pragma unroll
        for (int u = 0; u < 4; ++u) {
            const int it = it0 + u * ngrp, tok = it / 10, hh = it - tok * 10;
            bf16* p = P0 + (size_t)tok * L0N + hh * 64 + 8 * sub;
            const u32x4_t w = wv[u];
            float v[8] = {bflo(w.x), bfhi(w.x), bflo(w.y), bfhi(w.y), bflo(w.z), bfhi(w.z), bflo(w.w), bfhi(w.w)};
            float ss = 0.f;
#pragma unroll
            for (int j = 0; j < 8; ++j) ss += v[j] * v[j];
            ss += __shfl_xor(ss, 1); ss += __shfl_xor(ss, 2); ss += __shfl_xor(ss, 4);
            const float r = 1.0f / sqrtf(ss * (1.f / 64.f) + RMS_EPS);
            const float* g = ((hh < 8) ? qg : kg) + 8 * sub;
            const f32x4_t g0 = *(const f32x4_t*)g, g1 = *(const f32x4_t*)(g + 4);
            const float gv[8] = {g0.x, g0.y, g0.z, g0.w, g1.x, g1.y, g1.z, g1.w};
            const float sc = (hh < 8) ? (0.125f * 1.4426950408889634f) : 1.0f;
            const int s = tok % SEQ, row = s >> 6, col = s & 63;
            const f32x4_t* tp = (const f32x4_t*)(tabA + ((s3 < 2) ? (row * 16 + 8 * s3) : (col * 16 + 8 * (s3 - 2))));
            const f32x4_t t0 = tp[0], t1 = tp[1], t2 = tp[2], t3 = tp[3];
            const float cs[8] = {t0.x, t0.z, t1.x, t1.z, t2.x, t2.z, t3.x, t3.z}, sn[8] = {t0.y, t0.w, t1.y, t1.w, t2.y, t2.w, t3.y, t3.w};
            float o[8];
#pragma unroll
            for (int j = 0; j < 8; ++j) {
                const float y = v[j] * r * gv[j];
                const float pv = __shfl_xor(y, 4);
                o[j] = ((sub < 4) ? (y * cs[j] - pv * sn[j]) : (pv * sn[j] + y * cs[j])) * sc;
            }
            u32x4_t wo; wo.x = pk2(o[0], o[1]); wo.y = pk2(o[2], o[3]); wo.z = pk2(o[4], o[5]); wo.w = pk2(o[6], o[7]);
            *(u32x4_t*)p = wo;
        }
    }
}

__device__ __forceinline__ void conv_phase(char* lds, const bf16* P0, const float* dww, const float* dwb, const float* ng, const float* nb, bf16* AC, int bid, int G) {
    const int tid = threadIdx.x, lane = tid & 63, wave = tid >> 6;
    bf16* zin = (bf16*)lds;
    float* cz = (float*)(lds + 63488);
    const int cp = tid & 255, half = tid >> 8;
    for (int tile = bid; tile < M / 32; tile += G) {
        const int tok0 = tile * 32, b = tok0 / SEQ, s0 = tok0 % SEQ;
        for (int it = tid; it < 62 * 64; it += NTHR) {
            const int r = it >> 6, cgp = it & 63, sp = s0 - 15 + r;
            u32x4_t w = (u32x4_t){0u, 0u, 0u, 0u};
            if (sp >= 0 && sp < SEQ) {
                const bf16* pr = P0 + (size_t)(b * SEQ + sp) * L0N;
                const u32x4_t a = *(const u32x4_t*)(pr + 768 + 8 * cgp), g = *(const u32x4_t*)(pr + 1280 + 8 * cgp);
                w.x = pk2(bflo(a.x) * sigmoid_f(bflo(g.x)), bfhi(a.x) * sigmoid_f(bfhi(g.x)));
                w.y = pk2(bflo(a.y) * sigmoid_f(bflo(g.y)), bfhi(a.y) * sigmoid_f(bfhi(g.y)));
                w.z = pk2(bflo(a.z) * sigmoid_f(bflo(g.z)), bfhi(a.z) * sigmoid_f(bfhi(g.z)));
                w.w = pk2(bflo(a.w) * sigmoid_f(bflo(g.w)), bfhi(a.w) * sigmoid_f(bfhi(g.w)));
            }
            *(u32x4_t*)(zin + r * 512 + 8 * cgp) = w;
        }
        __syncthreads();
        {
            float a0[16], a1[16];
            const float b0 = dwb[2 * cp], b1 = dwb[2 * cp + 1];
#pragma unroll
            for (int t = 0; t < 16; ++t) { a0[t] = b0; a1[t] = b1; }
            float w0[31], w1[31];
#pragma unroll
            for (int j = 0; j < 31; ++j) { const float2 ww = *(const float2*)(dww + j * 512 + 2 * cp); w0[j] = ww.x; w1[j] = ww.y; }
#pragma unroll
            for (int r = 0; r < 46; ++r) {
                const unsigned zz = *(const unsigned*)(zin + (16 * half + r) * 512 + 2 * cp);
                const float z0 = bflo(zz), z1 = bfhi(zz);
#pragma unroll
                for (int t = 0; t < 16; ++t) { const int j = r - t; if (j >= 0 && j < 31) { a0[t] += z0 * w0[j]; a1[t] += z1 * w1[j]; } }
            }
#pragma unroll
            for (int t = 0; t < 16; ++t) *(float2*)(cz + (16 * half + t) * 512 + 2 * cp) = make_float2(a0[t], a1[t]);
        }
        __syncthreads();
#pragma unroll
        for (int q = 0; q < 4; ++q) {
            const int tk = 4 * wave + q;
            const f32x4_t v0 = *(const f32x4_t*)(cz + tk * 512 + 8 * lane), v1 = *(const f32x4_t*)(cz + tk * 512 + 8 * lane + 4);
            const float mean = wave_sum((v0.x + v0.y) + (v0.z + v0.w) + (v1.x + v1.y) + (v1.z + v1.w)) * (1.f / 512.f);
            const f32x4_t d0 = v0 - mean, d1 = v1 - mean;
            const float var = wave_sum((d0.x * d0.x + d0.y * d0.y) + (d0.z * d0.z + d0.w * d0.w) + (d1.x * d1.x + d1.y * d1.y) + (d1.z * d1.z + d1.w * d1.w)) * (1.f / 512.f);
            const float rstd = 1.f / sqrtf(var + LN_EPS);
            const f32x4_t g0 = *(const f32x4_t*)(ng + 8 * lane), g1 = *(const f32x4_t*)(ng + 8 * lane + 4), e0 = *(const f32x4_t*)(nb + 8 * lane), e1 = *(const f32x4_t*)(nb + 8 * lane + 4);
            const f32x4_t y0 = d0 * rstd * g0 + e0, y1 = d1 * rstd * g1 + e1;
            u32x4_t w;
            w.x = pk2(y0.x * sigmoid_f(y0.x), y0.y * sigmoid_f(y0.y)); w.y = pk2(y0.z * sigmoid_f(y0.z), y0.w * sigmoid_f(y0.w));
            w.z = pk2(y1.x * sigmoid_f(y1.x), y1.y * sigmoid_f(y1.y)); w.w = pk2(y1.z * sigmoid_f(y1.z), y1.w * sigmoid_f(y1.w));
            *(u32x4_t*)(AC + (size_t)(tok0 + tk) * DMODEL + 512 + 8 * lane) = w;
        }
        __syncthreads();
    }
}

__device__ __forceinline__ void rope1_phase(bf16* QKV, const float2* tabR, int gtid, int gthreads) {
    for (int it = gtid; it < M * 128; it += gthreads) {
        const int grp = it & 15, hh = (it >> 4) & 7, tok = it >> 7;
        const int i0 = 8 * grp, s = tok % SEQ, row = s >> 6, col = s & 63;
        bf16* p = QKV + (size_t)tok * L1QKV + hh * 256 + i0;
        const u32x4_t x1 = *(const u32x4_t*)p, x2 = *(const u32x4_t*)(p + 128);
        const float2* tb = (i0 < 64) ? (tabR + row * 64 + i0) : (tabR + col * 64 + (i0 - 64));
        const float sc = (hh >= 4) ? 0.0625f : 1.0f;
        float a[8] = {bflo(x1.x), bfhi(x1.x), bflo(x1.y), bfhi(x1.y), bflo(x1.z), bfhi(x1.z), bflo(x1.w), bfhi(x1.w)};
        float b[8] = {bflo(x2.x), bfhi(x2.x), bflo(x2.y), bfhi(x2.y), bflo(x2.z), bfhi(x2.z), bflo(x2.w), bfhi(x2.w)};
        float oa[8], ob[8];
#pragma unroll
        for (int j = 0; j < 8; ++j) { const float2 cs = tb[j]; oa[j] = (a[j] * cs.x - b[j] * cs.y) * sc; ob[j] = (a[j] * cs.y + b[j] * cs.x) * sc; }
        u32x4_t w1, w2;
        w1.x = pk2(oa[0], oa[1]); w1.y = pk2(oa[2], oa[3]); w1.z = pk2(oa[4], oa[5]); w1.w = pk2(oa[6], oa[7]);
        w2.x = pk2(ob[0], ob[1]); w2.y = pk2(ob[2], ob[3]); w2.z = pk2(ob[4], ob[5]); w2.w = pk2(ob[6], ob[7]);
        *(u32x4_t*)p = w1; *(u32x4_t*)(p + 128) = w2;
    }
}

#define XB_TMO      128
#define XB_XCNT(j)  (256  + 64 * (j))
#define XB_XSUB(j)  (1280 + 64 * (j))
#define XB_XGEN(j)  (2304 + 64 * (j))
#define XB_TOP      3328
#define XB_TOPGEN   3392
#define XCD_BAR_WORDS 3456
#define XB_SPIN_CAP (1u << 18)

__device__ __forceinline__ unsigned xb_ld(unsigned* p)              { return __hip_atomic_load(p, __ATOMIC_RELAXED, __HIP_MEMORY_SCOPE_AGENT); }
__device__ __forceinline__ unsigned xb_add(unsigned* p, unsigned v) { return __hip_atomic_fetch_add(p, v, __ATOMIC_RELAXED, __HIP_MEMORY_SCOPE_AGENT); }
__device__ __forceinline__ unsigned xb_xcc_id() { return (unsigned)__builtin_amdgcn_s_getreg((3 << 11) | 20) & 0xFu; }
#define XB_SPIN(cond, bar) do { unsigned _sp = 0; while (cond) { __builtin_amdgcn_s_sleep(1); \
    if ((++_sp & 255u) == 0u) { if (xb_ld(&(bar)[XB_TMO])) break; if (_sp > XB_SPIN_CAP) { atomicAdd(&(bar)[XB_TMO], 1u); break; } } } } while (0)

struct XcdBarrier {
    unsigned* bar; unsigned x;
    volatile LAS unsigned* st;
};

__device__ __forceinline__ XcdBarrier xcd_barrier_post(unsigned* bar, volatile LAS unsigned* st) {
    XcdBarrier b; b.bar = bar; b.x = xb_xcc_id(); b.st = st;
    if (threadIdx.x == 0) (void)xb_add(&bar[XB_XCNT(b.x)], 1u);
    return b;
}
__device__ __forceinline__ void xcd_barrier_complete(unsigned* bar, unsigned x, unsigned& nloc, unsigned& nx) {
    const unsigned G = gridDim.x * gridDim.y * gridDim.z;
    unsigned sum, cnt, mine, sp = 0u;
    for (;;) {
        sum = 0u; cnt = 0u; mine = 0u;
#pragma unroll
        for (unsigned j = 0; j < 16; ++j) { const unsigned c = xb_ld(&bar[XB_XCNT(j)]); sum += c; cnt += (c > 0u) ? 1u : 0u; mine = (j == x) ? c : mine; }
        if (sum == G) break;
        __builtin_amdgcn_s_sleep(1);
        if ((++sp & 255u) == 0u) { if (xb_ld(&bar[XB_TMO])) break; if (sp > XB_SPIN_CAP) { atomicAdd(&bar[XB_TMO], 1u); break; } }
    }
    nloc = mine > 0u ? mine : 1u; nx = cnt > 0u ? cnt : 1u;
}

__device__ __forceinline__ void xcd_barrier(const XcdBarrier& b) {
    asm volatile("s_waitcnt vmcnt(0)" ::: "memory");
    __syncthreads();
    if (threadIdx.x == 0) {
        unsigned* bar = b.bar;
        __builtin_amdgcn_s_waitcnt(0);
        unsigned nloc = b.st[0], nx = b.st[1];
        if (nloc == 0u) { xcd_barrier_complete(bar, b.x, nloc, nx); b.st[0] = nloc; b.st[1] = nx; }
        const unsigned old = xb_add(&bar[XB_XSUB(b.x)], 1u);
        const unsigned gen = old / nloc;
        if (old + 1u == (gen + 1u) * nloc) {
            __builtin_amdgcn_fence(__ATOMIC_RELEASE, "agent");
            asm volatile("s_waitcnt vmcnt(0)" ::: "memory");
            const unsigned og = xb_add(&bar[XB_TOP], 1u);
            const unsigned tg = og / nx;
            if (og + 1u == (tg + 1u) * nx) xb_add(&bar[XB_TOPGEN], 1u);
            else XB_SPIN(xb_ld(&bar[XB_TOPGEN]) == tg, bar);
            __builtin_amdgcn_fence(__ATOMIC_ACQUIRE, "agent");
            xb_add(&bar[XB_XGEN(b.x)], 1u);
            asm volatile("s_waitcnt vmcnt(0)" ::: "memory");
        } else {
            XB_SPIN(xb_ld(&bar[XB_XGEN(b.x)]) == gen, bar);
            __builtin_amdgcn_fence(__ATOMIC_ACQUIRE, "agent");
            asm volatile("s_waitcnt vmcnt(0)" ::: "memory");
        }
    }
    __syncthreads();
}
constexpr int RSEG = 4, RSEGC = 32;
template <bool PASS3, int VAR = 0>
__device__ __forceinline__ void sweep_pass(char* lds, const bf16* QKV, bf16* Oi, float* LST, const float* lgf, const float* lgb, int vcu, int G) {
    const int tid = threadIdx.x, lane = tid & 63, w = __builtin_amdgcn_readfirstlane(tid >> 6), l15 = lane & 15, quad = lane >> 4;
    constexpr int KSP = 264, VSP = 72, OFF_V = 128 * KSP * 2, OFF_ST = OFF_V + 128 * VSP * 2;
    bf16* Ks = (bf16*)lds;
    bf16* Vs = (bf16*)(lds + OFF_V);
    bf16* St = (bf16*)(lds + OFF_ST);
    const LAS char* Ks3 = (const LAS char*)(LAS unsigned char*)(lds);
    const LAS char* Vs3 = Ks3 + OFF_V;
    const unsigned kbase0 = (unsigned)(uintptr_t)lds + (unsigned)(((8 * quad + (l15 >> 2)) * KSP + 32 * w + 4 * (l15 & 3)) * 2);
    const unsigned vbase0 = (unsigned)(uintptr_t)lds + (unsigned)(OFF_V + ((8 * quad + (l15 >> 2)) * VSP + 4 * (l15 & 3)) * 2);
    for (int unit = vcu; unit < 256; unit += G) {
        const int sl = unit & 7, seg = (unit >> 3) & 3, h = (unit >> 5) & 3, b = unit >> 7;
        const bf16* Qg = QKV + (size_t)(b * 4 + h) * SEQ * 256;
        const bf16* Kg = Qg + (size_t)M * 1024;
        const bf16* Vg = QKV + (size_t)M * 2048 + (size_t)(b * 4 + h) * SEQ * 512 + 64 * sl;
        bf16* Og = Oi + (size_t)b * SEQ * RVW + h * 512 + 64 * sl + 4 * quad;
        for (int dir = 0; dir < 2; ++dir) {
            if (!PASS3 && ((dir == 0 && seg == RSEG - 1) || (dir == 1 && seg == 0))) continue;
            const float lg = dir ? lgb[h] : lgf[h];
            const float l2 = lg * 1.4426950408889634f;
            const float decayC = exp2f(l2 * 128.f);
            float* Lbase = LST + ((size_t)((b * 4 + h) * 2 + dir) * 3) * (256 * 512) + 64 * sl;
            f32x4_t accs[2][4];
#pragma unroll
            for (int mt = 0; mt < 2; ++mt)
#pragma unroll
                for (int nt = 0; nt < 4; ++nt) accs[mt][nt] = (f32x4_t){0.f, 0.f, 0.f, 0.f};
            if (PASS3) {
#pragma unroll
                for (int s2 = 0; s2 < RSEG; ++s2) {
                    const bool use = dir ? (s2 > seg) : (s2 < seg);
                    if (use) {
                        const int dist = dir ? (s2 - seg - 1) : (seg - 1 - s2);
                        const float wgt = exp2f(l2 * 4096.f * (float)dist);
                        const float* Ls = Lbase + (size_t)(dir ? s2 - 1 : s2) * (256 * 512);
#pragma unroll
                        for (int mt = 0; mt < 2; ++mt)
#pragma unroll
                            for (int nt = 0; nt < 4; ++nt)
#pragma unroll
                                for (int j = 0; j < 4; ++j) accs[mt][nt][j] += wgt * Ls[(size_t)(32 * w + 16 * mt + 4 * quad + j) * 512 + 16 * nt + l15];
                    }
                }
            }
            const float qd = exp2f(l2 * (float)(dir ? (128 - (16 * w + l15)) : (16 * w + l15 + 1)));
            float kdr[2];
#pragma unroll
            for (int j = 0; j < 2; ++j) { const int row = (tid + NTHR * j) >> 3; kdr[j] = exp2f(l2 * (float)(dir ? row : (127 - row))); }
            constexpr int NB = PASS3 ? 1 : 2;
            u32x4_t kreg[NB][8], vreg[NB][2]; bf16x8_t qreg[8]; u32x2_t oreg[4];
            const int c0 = seg * RSEGC + (dir ? RSEGC - 1 : 0);
            const unsigned koff = (unsigned)(tid * 8), voff = (unsigned)((tid >> 3) * 512 + (tid & 7) * 8);
            const unsigned qoff = (unsigned)((16 * w + l15) * 256 + 8 * quad), ooff = (unsigned)((16 * w + l15) * RVW);
#define SW_LOAD(c, B) do { const bf16* kc_ = Kg + (size_t)(c) * 128 * 256; const bf16* vc_ = Vg + (size_t)(c) * 128 * 512; \
                _Pragma("unroll") for (int j = 0; j < 8; ++j) kreg[B][j] = *(const u32x4_t*)(kc_ + (size_t)j * 16 * 256 + koff); \
                _Pragma("unroll") for (int j = 0; j < 2; ++j) vreg[B][j] = *(const u32x4_t*)(vc_ + (size_t)j * 64 * 512 + voff); \
            } while (0)
#define SW_LOADQ(c) do { if (PASS3) { const bf16* qc_ = Qg + (size_t)(c) * 128 * 256; \
                _Pragma("unroll") for (int ks = 0; ks < 8; ++ks) qreg[ks] = *(const bf16x8_t*)(qc_ + 32 * ks + qoff); \
                if (dir) { const bf16* oc_ = Og + (size_t)(c) * 128 * RVW; _Pragma("unroll") for (int nt = 0; nt < 4; ++nt) oreg[nt] = *(const u32x2_t*)(oc_ + 16 * nt + ooff); } } \
            } while (0)
            SW_LOAD(c0, 0); if (NB == 2) SW_LOAD(dir ? c0 - 1 : c0 + 1, NB - 1);
#pragma unroll
            for (int i = 0; i < RSEGC; ++i) {
                const int c = dir ? c0 - i : c0 + i;
                if (!(VAR & 8))
#pragma unroll
                for (int j = 0; j < 8; ++j) { const int idx = tid + NTHR * j, row = idx >> 5, c16 = idx & 31; *(u32x4_t*)(Ks + row * KSP + c16 * 8) = kreg[i & (NB - 1)][j]; }
#pragma unroll
                for (int j = 0; j < 2; ++j) { const int idx = tid + NTHR * j, row = idx >> 3, c16 = idx & 7; const u32x4_t k4 = vreg[i & (NB - 1)][j]; const float kk = kdr[j]; u32x4_t o4;
                    o4.x = pk2(bflo(k4.x) * kk, bfhi(k4.x) * kk); o4.y = pk2(bflo(k4.y) * kk, bfhi(k4.y) * kk); o4.z = pk2(bflo(k4.z) * kk, bfhi(k4.z) * kk); o4.w = pk2(bflo(k4.w) * kk, bfhi(k4.w) * kk);
                    *(u32x4_t*)(Vs + row * VSP + c16 * 8) = o4; }
                if (PASS3) {
#pragma unroll
                    for (int mt = 0; mt < 2; ++mt)
#pragma unroll
                        for (int nt = 0; nt < 4; ++nt) { u32x2_t sw; sw.x = pk2(accs[mt][nt].x, accs[mt][nt].y); sw.y = pk2(accs[mt][nt].z, accs[mt][nt].w);
                            *(u32x2_t*)(St + (16 * nt + l15) * KSP + 32 * w + 16 * mt + 4 * quad) = sw; }
                }
                asm volatile("s_waitcnt lgkmcnt(0)" ::: "memory"); __builtin_amdgcn_s_barrier(); asm volatile("" ::: "memory");
                if (!(VAR & 4)) SW_LOADQ(c);
                if (!(VAR & 4) && i + NB < RSEGC) { const int cn = dir ? c - NB : c + NB; SW_LOAD(cn, i & (NB - 1)); }
#pragma unroll
                for (int mt = 0; mt < 2; ++mt)
#pragma unroll
                    for (int nt = 0; nt < 4; ++nt) accs[mt][nt] = accs[mt][nt] * decayC;
                if (!(VAR & 1))
#pragma unroll
                for (int ks = 0; ks < 4; ++ks) {
                    unsigned kb_ = kbase0, vb_ = vbase0; asm volatile("" : "+v"(kb_), "+v"(vb_));
                    const LAS char* kp_ = (const LAS char*)kb_; const LAS char* vp_ = (const LAS char*)vb_;
                    bf16x8_t afr[2], bfr[4];
#pragma unroll
                    for (int mt = 0; mt < 2; ++mt) {
                        const s16x4_t klo = tr_read(kp_ + ((32 * ks) * KSP + 16 * mt) * 2), khi = tr_read(kp_ + ((32 * ks + 4) * KSP + 16 * mt) * 2);
                        afr[mt] = (bf16x8_t){klo[0], klo[1], klo[2], klo[3], khi[0], khi[1], khi[2], khi[3]}; }
#pragma unroll
                    for (int nt = 0; nt < 4; ++nt) {
                        const s16x4_t vlo = tr_read(vp_ + ((32 * ks) * VSP + 16 * nt) * 2), vhi = tr_read(vp_ + ((32 * ks + 4) * VSP + 16 * nt) * 2);
                        bfr[nt] = (bf16x8_t){vlo[0], vlo[1], vlo[2], vlo[3], vhi[0], vhi[1], vhi[2], vhi[3]}; }
#pragma unroll
                    for (int mt = 0; mt < 2; ++mt)
#pragma unroll
                        for (int nt = 0; nt < 4; ++nt) accs[mt][nt] = __builtin_amdgcn_mfma_f32_16x16x32_bf16(afr[mt], bfr[nt], accs[mt][nt], 0, 0, 0);
                }
                if (PASS3 && !(VAR & 2)) {
                    f32x4_t o[4];
#pragma unroll
                    for (int nt = 0; nt < 4; ++nt) o[nt] = (f32x4_t){0.f, 0.f, 0.f, 0.f};
#pragma unroll
                    for (int ks = 0; ks < 8; ++ks)
#pragma unroll
                        for (int nt = 0; nt < 4; ++nt) { const bf16x8_t afr = *(const bf16x8_t*)(St + (16 * nt + l15) * KSP + 32 * ks + 8 * quad); o[nt] = __builtin_amdgcn_mfma_f32_16x16x32_bf16(afr, qreg[ks], o[nt], 0, 0, 0); }
#pragma unroll
                    for (int nt = 0; nt < 4; ++nt) {
                        f32x4_t ov = o[nt] * qd;
                        if (dir) { ov.x += bflo(oreg[nt].x); ov.y += bfhi(oreg[nt].x); ov.z += bflo(oreg[nt].y); ov.w += bfhi(oreg[nt].y); }
                        u32x2_t t; t.x = pk2(ov.x, ov.y); t.y = pk2(ov.z, ov.w);
                        *(u32x2_t*)(Og + (size_t)c * 128 * RVW + 16 * nt + ooff) = t;
                    }
                }
                asm volatile("s_waitcnt lgkmcnt(0)" ::: "memory"); __builtin_amdgcn_s_barrier(); asm volatile("" ::: "memory");
            }
#undef SW_LOAD
#undef SW_LOADQ
            if (!PASS3) {
                float* Ls = Lbase + (size_t)(dir ? seg - 1 : seg) * (256 * 512);
#pragma unroll
                for (int mt = 0; mt < 2; ++mt)
#pragma unroll
                    for (int nt = 0; nt < 4; ++nt)
#pragma unroll
                        for (int j = 0; j < 4; ++j) Ls[(size_t)(32 * w + 16 * mt + 4 * quad + j) * 512 + 16 * nt + l15] = accs[mt][nt][j];
            }
        }
    }
}

__device__ __forceinline__ void intra_phase(char* lds, const bf16* QKV, bf16* Oi, const float* lgf, const float* lgb, const float* gn, int vcu, int G) {
    const int tid = threadIdx.x, lane = tid & 63, w = __builtin_amdgcn_readfirstlane(tid >> 6), l15 = lane & 15, quad = lane >> 4;
    constexpr int VSP = 520, KSP = 264;
    bf16* Vs = (bf16*)lds;
    bf16* Ks = (bf16*)lds;
    const LAS char* Vs3 = (const LAS char*)(LAS unsigned char*)(lds);
    for (int unit = vcu; unit < 1024; unit += G) {
        const int b = unit >> 9, h = (unit >> 7) & 3, c = unit & 127;
        const size_t tokb = (size_t)b * SEQ + (size_t)c * 128;
        const size_t hrow = (size_t)(b * 4 + h) * SEQ + (size_t)c * 128;
        const float l2f = lgf[h] * 1.4426950408889634f, l2b = lgb[h] * 1.4426950408889634f;
        {
            const bf16* ksrc = QKV + (size_t)M * 1024 + hrow * 256;
            const unsigned koff = (unsigned)(tid * 8);
            bf16* kdst = Ks + (tid >> 5) * KSP + (tid & 31) * 8;
            u32x4_t kreg[8];
#pragma unroll
            for (int j = 0; j < 8; ++j) kreg[j] = *(const u32x4_t*)(ksrc + (size_t)j * 16 * 256 + koff);
#pragma unroll
            for (int j = 0; j < 8; ++j) *(u32x4_t*)(kdst + j * 16 * KSP) = kreg[j];
        }
        bf16x8_t qf[8];
#pragma unroll
        for (int ks = 0; ks < 8; ++ks) qf[ks] = *(const bf16x8_t*)(QKV + (hrow + 16 * w + l15) * 256 + 32 * ks + 8 * quad);
        __syncthreads();
        u32x4_t vreg[16];
        {
            const bf16* vsrc = QKV + (size_t)M * 2048 + hrow * 512 + (unsigned)(tid * 8);
#pragma unroll
            for (int j = 0; j < 16; ++j) vreg[j] = *(const u32x4_t*)(vsrc + (size_t)(8 * j) * 512);
        }
        bf16* vdst = Vs + (tid >> 6) * VSP + (tid & 63) * 8;
        __builtin_amdgcn_sched_barrier(0);
        bf16x8_t Bp[4];
        const unsigned kfb0 = (unsigned)(uintptr_t)lds + (unsigned)((l15 * KSP + 8 * quad) * 2);
        int nq = 16 * w + l15; asm volatile("" : "+v"(nq));
#pragma unroll
        for (int a = 0; a < 4; ++a) {
            unsigned pw[4];
#pragma unroll
            for (int e = 0; e < 2; ++e) {
                const int mt = 2 * a + e;
                f32x4_t C = (f32x4_t){0.f, 0.f, 0.f, 0.f};
                unsigned kb_ = kfb0; asm volatile("" : "+v"(kb_)); const LAS char* kp_ = (const LAS char*)kb_;
#pragma unroll
                for (int ks = 0; ks < 8; ++ks) { const bf16x8_t af = *(const LAS bf16x8_t*)(kp_ + ((16 * mt) * KSP + 32 * ks) * 2);
                    C = __builtin_amdgcn_mfma_f32_16x16x32_bf16(af, qf[ks], C, 0, 0, 0); }
                float pv[4];
#pragma unroll
                for (int j = 0; j < 4; ++j) { const int mk = 16 * mt + 4 * quad + j; const int d = nq - mk;
                    const float dec = (d >= 0) ? exp2f(l2f * (float)d) : exp2f(l2b * (float)(-d)); pv[j] = C[j] * dec; }
                pw[2 * e] = pk2(pv[0], pv[1]); pw[2 * e + 1] = pk2(pv[2], pv[3]);
                __builtin_amdgcn_sched_barrier(0);
            }
            Bp[a] = __builtin_bit_cast(bf16x8_t, (u32x4_t){pw[0], pw[1], pw[2], pw[3]});
        }
        __builtin_amdgcn_sched_barrier(0);
        __syncthreads();
#pragma unroll
        for (int j = 0; j < 16; ++j) *(u32x4_t*)(vdst + (8 * j) * VSP) = vreg[j];
        __builtin_amdgcn_sched_barrier(0);
        bf16* orow = Oi + (tokb + 16 * w + l15) * RVW + h * 512 + 4 * quad;
        __syncthreads();
        const int r0b = 4 * quad + (l15 >> 2), cbb = 4 * (l15 & 3);
        const unsigned vbase0 = (unsigned)(uintptr_t)lds + (unsigned)((r0b * VSP + cbb) * 2);
#define PV_TILE(dt, A, OIN) do { A = (f32x4_t){0.f, 0.f, 0.f, 0.f}; unsigned vb_ = vbase0; asm volatile("" : "+v"(vb_)); const LAS char* vp_ = (const LAS char*)vb_; \
            _Pragma("unroll") for (int a = 0; a < 4; ++a) { \
                const s16x4_t lo = tr_read(vp_ + ((32 * a) * VSP + 16 * (dt)) * 2), hi = tr_read(vp_ + ((32 * a + 16) * VSP + 16 * (dt)) * 2); \
                const bf16x8_t af = (bf16x8_t){lo[0], lo[1], lo[2], lo[3], hi[0], hi[1], hi[2], hi[3]}; \
                A = __builtin_amdgcn_mfma_f32_16x16x32_bf16(af, Bp[a], A, 0, 0, 0); } \
            A.x += bflo((OIN).x); A.y += bfhi((OIN).x); A.z += bflo((OIN).y); A.w += bfhi((OIN).y); } while (0)
        float s = 0.f, q = 0.f;
#pragma unroll 1
        for (int hf = 0; hf < 2; ++hf) {
            u32x2_t oin[16];
#pragma unroll
            for (int d2 = 0; d2 < 16; ++d2) oin[d2] = *(const u32x2_t*)(orow + 256 * hf + 16 * d2);
#pragma unroll
            for (int d2 = 0; d2 < 16; ++d2) { f32x4_t A; PV_TILE(16 * hf + d2, A, oin[d2]); s += (A.x + A.y) + (A.z + A.w); q += (A.x * A.x + A.y * A.y) + (A.z * A.z + A.w * A.w); __builtin_amdgcn_sched_barrier(0); }
        }
        s += __shfl_xor(s, 16); s += __shfl_xor(s, 32); q += __shfl_xor(q, 16); q += __shfl_xor(q, 32);
        const float mean = s * (1.f / 512.f);
        const float var = fmaxf(q * (1.f / 512.f) - mean * mean, 0.f);
        const float rstd = 1.f / sqrtf(var + LN_EPS);
        const float* gnp = gn + h * 512 + 4 * quad;
#pragma unroll 1
        for (int hf = 0; hf < 2; ++hf) {
            u32x2_t oin[16];
#pragma unroll
            for (int d2 = 0; d2 < 16; ++d2) oin[d2] = *(const u32x2_t*)(orow + 256 * hf + 16 * d2);
#pragma unroll
            for (int d2 = 0; d2 < 16; ++d2) { f32x4_t A; PV_TILE(16 * hf + d2, A, oin[d2]); const f32x4_t gg = *(const f32x4_t*)(gnp + 256 * hf + 16 * d2); const f32x4_t y = (A - mean) * rstd * gg;
                u32x2_t t; t.x = pk2(y.x, y.y); t.y = pk2(y.z, y.w); *(u32x2_t*)(orow + 256 * hf + 16 * d2) = t; __builtin_amdgcn_sched_barrier(0); }
        }
#undef PV_TILE
        __syncthreads();
    }
}

#ifndef REP0
#define REP0 1
#endif
#ifndef REP1
#define REP1 1
#endif
#ifndef REP2
#define REP2 1
#endif
#ifndef REP3
#define REP3 1
#endif
#ifndef REP4
#define REP4 1
#endif
#ifndef REP5
#define REP5 1
#endif
#ifndef REP6
#define REP6 1
#endif
#ifndef REP7
#define REP7 1
#endif
#ifndef REP8
#define REP8 1
#endif
#ifndef REP9
#define REP9 1
#endif
#ifndef REP10
#define REP10 1
#endif
#ifndef REP11
#define REP11 1
#endif
#ifndef REP12
#define REP12 1
#endif
#ifndef REP13
#define REP13 1
#endif
#ifndef REP14
#define REP14 1
#endif
#ifndef REP15
#define REP15 1
#endif
#ifndef REP16
#define REP16 1
#endif
#ifndef REP17
#define REP17 1
#endif
#ifndef REP18
#define REP18 1
#endif
#ifndef REP19
#define REP19 1
#endif
#ifndef NOP0
#define NOP0 0
#endif
#ifndef NOP1
#define NOP1 0
#endif
#ifndef NOP2
#define NOP2 0
#endif
#ifndef NOP3
#define NOP3 0
#endif
#ifndef NOP4
#define NOP4 0
#endif
#ifndef NOP5
#define NOP5 0
#endif
#ifndef NOP6
#define NOP6 0
#endif
#ifndef NOP7
#define NOP7 0
#endif
#ifndef NOP8
#define NOP8 0
#endif
#ifndef NOP9
#define NOP9 0
#endif
#ifndef NOP10
#define NOP10 0
#endif
#ifndef NOP11
#define NOP11 0
#endif
#ifndef NOP12
#define NOP12 0
#endif
#ifndef NOP13
#define NOP13 0
#endif
#ifndef NOP14
#define NOP14 0
#endif
#ifndef NOP15
#define NOP15 0
#endif
#ifndef NOP16
#define NOP16 0
#endif
#ifndef NOP17
#define NOP17 0
#endif
#ifndef NOP18
#define NOP18 0
#endif
#ifndef NOP19
#define NOP19 0
#endif
__global__ void __launch_bounds__(NTHR, 2) mk_fwd(Args args) {
    extern __shared__ __attribute__((aligned(16))) unsigned char lds[];
    cg::grid_group grid = cg::this_grid();
    const int tid = threadIdx.x, lane = tid & 63, wave = __builtin_amdgcn_readfirstlane(tid >> 6);
    const int G = gridDim.x, bid = blockIdx.x;
    const int vcu = (G % 8 == 0) ? (bid % 8) * (G / 8) + bid / 8 : bid;
    const int gtid = bid * NTHR + tid, gthreads = G * NTHR;
    unsigned char* ws = args.ws;
    const float* x = args.in[0];
    float* out = args.out;
    bf16* W0IN = (bf16*)(ws + WS_W0IN); bf16* W0OUT = (bf16*)(ws + WS_W0OUT); bf16* W0GU = (bf16*)(ws + WS_W0GU); bf16* W0D = (bf16*)(ws + WS_W0D);
    bf16* W1IN = (bf16*)(ws + WS_W1IN); bf16* W1OUT = (bf16*)(ws + WS_W1OUT); bf16* W1GU = (bf16*)(ws + WS_W1GU); bf16* W1D = (bf16*)(ws + WS_W1D);
    float2* tabA = (float2*)(ws + WS_TABA); float2* tabR = (float2*)(ws + WS_TABR);
    bf16* XB = (bf16*)(ws + WS_XB); bf16* AC = (bf16*)(ws + WS_AC); bf16* PROJ0 = (bf16*)(ws + WS_PROJ0);
    float* Y = (float*)(ws + WS_Y); bf16* H = (bf16*)(ws + WS_H); bf16* OI = (bf16*)(ws + WS_OI); bf16* QKV = (bf16*)(ws + WS_QKV); float* Y1 = (float*)(ws + WS_Y1);
    const int lo = args.ph_lo, hi = args.ph_hi;
    volatile LAS unsigned* xb_st = (volatile LAS unsigned*)((LAS unsigned char*)lds + 147440);
    if (tid < 2) xb_st[tid] = 0u;
    __syncthreads();
    XcdBarrier xbar = xcd_barrier_post((unsigned*)(ws + WS_BAR), xb_st);
#define IN(k) (lo <= (k) && (k) < hi)
#define SEAM(k) do { if (IN(k) && IN((k) + 1)) { if ((k) == 0) grid.sync(); else xcd_barrier(xbar); } } while (0)
#define GEMM_RUN(EPI, Aptr, Bptr, Nn, Kk, ...) do { pg8::Gemm g{(const pg8::bf16_t*)(Aptr), (const pg8::bf16_t*)(Bptr), M, (Nn), (Kk)}; pg8::StaticOrder S; S.init(M, (Nn), G, bid); \
        pg8::EPI E{__VA_ARGS__}; pg8::gemm_phase<pg8::EPI, pg8::StaticOrder, true, true>((LAS unsigned char*)lds, g, S, E); } while (0)

    if (IN(0) && !NOP0) {
        LAS float* scr = (LAS float*)((LAS unsigned char*)lds + wave * 16384);
        const int gw = bid * NWAVES + wave, NGW = G * NWAVES;
        constexpr int I0 = 16 * (L0N / 32), I1 = 16 * 32, I2 = 16 * (FFH / 32), I3 = (FFH / 64) * 32, I4 = 16 * (6144 / 32), I5 = 32 * 32;
        constexpr int NITEMS = I0 + I1 + 2 * I2 + I3 + I4 + I5 + 2 * I2 + I3;
        for (int it = gw; it < NITEMS; it += NGW) {
            int r = it;
            if (r < I0) { p0_transpose_item(args.in[1], 1024, L0N, W0IN, 0, scr, r, lane); continue; } r -= I0;
            if (r < I1) { p0_transpose_item(args.in[8], 1024, 1024, W0OUT, 0, scr, r, lane); continue; } r -= I1;
            if (r < I2) { p0_transpose_item(args.in[11], 1024, FFH, W0GU, 1, scr, r, lane); continue; } r -= I2;
            if (r < I2) { p0_transpose_item(args.in[12], 1024, FFH, W0GU, 2, scr, r, lane); continue; } r -= I2;
            if (r < I3) { p0_transpose_item(args.in[13], FFH, 1024, W0D, 0, scr, r, lane); continue; } r -= I3;
            if (r < I4) { p0_transpose_item(args.in[16], 1024, 6144, W1IN, 0, scr, r, lane); continue; } r -= I4;
            if (r < I5) { p0_transpose_item(args.in[20], 2048, 1024, W1OUT, 0, scr, r, lane); continue; } r -= I5;
            if (r < I2) { p0_transpose_item(args.in[23], 1024, FFH, W1GU, 1, scr, r, lane); continue; } r -= I2;
            if (r < I2) { p0_transpose_item(args.in[24], 1024, FFH, W1GU, 2, scr, r, lane); continue; } r -= I2;
            p0_transpose_item(args.in[25], FFH, 1024, W1D, 0, scr, r, lane);
        }
        for (int i = gtid; i < M * DMODEL / 8; i += gthreads) {
            const f32x4_t a = ((const f32x4_t*)x)[2 * i], b = ((const f32x4_t*)x)[2 * i + 1];
            u32x4_t w; w.x = pk2(a.x, a.y); w.y = pk2(a.z, a.w); w.z = pk2(b.x, b.y); w.w = pk2(b.z, b.w);
            ((u32x4_t*)XB)[i] = w;
        }
        if (gtid < 256 * 16) { const int pos = gtid >> 4, j = gtid & 15; const float f = powf(10000.0f, -(float)(2 * j) / 32.0f); const float ang = (float)pos * f;
            tabA[gtid] = make_float2((float)cos((double)ang), (float)sin((double)ang)); }
        else if (gtid < 256 * 16 + 256 * 64) { const int k = gtid - 256 * 16, pos = k >> 6, j = k & 63; const float f = powf(10000.0f, -(float)(2 * j) / 128.0f); const float ang = (float)pos * f;
            tabR[k] = make_float2((float)cos((double)ang), (float)sin((double)ang)); }
    }
    SEAM(0);
    if (IN(1) && !NOP1) for (int rep_ = 0; rep_ < REP1; ++rep_) GEMM_RUN(EpiBf16, XB, W0IN, L0N, 1024, (pg8::bf16_t*)PROJ0, L0N);
    SEAM(1);
    if (IN(2) && !NOP2) {
        qk_norm_rope(PROJ0, args.in[2], args.in[3], tabA, gtid, gthreads);
        for (int rep_ = 0; rep_ < REP2; ++rep_) conv_phase((char*)lds, PROJ0, args.in[4], args.in[5], args.in[6], args.in[7], AC, bid, G);
    }
    SEAM(2);
    if (IN(3) && !NOP3) {
        for (int rep_ = 0; rep_ < REP3; ++rep_) for (int u = bid; u < 1024; u += G) {
            const int bkv = u >> 8, r = u & 255, b = bkv >> 1, kvh = bkv & 1, hq = kvh * 4 + (r >> 6), qb = r & 63;
            attn_body::attn_unit<8>(b, hq, kvh, qb, (const attn_body::bf16*)PROJ0, (const attn_body::bf16*)(PROJ0 + 512), (const attn_body::bf16*)(PROJ0 + 640), (attn_body::bf16*)AC, (char*)lds);
        }
    }
    SEAM(3);
    if (IN(4) && !NOP4) for (int rep_ = 0; rep_ < REP4; ++rep_) GEMM_RUN(EpiResF32, AC, W0OUT, 1024, 1024, x, Y, 1024, ALPHA);
    SEAM(4);
    if (IN(5) && !NOP5) for (int rep_ = 0; rep_ < REP5; ++rep_) ln_phase(Y, args.in[9], args.in[10], nullptr, XB, bid, G, wave, lane);
    SEAM(5);
    if (IN(6) && !NOP6) for (int rep_ = 0; rep_ < REP6; ++rep_) GEMM_RUN(EpiGateUp, XB, W0GU, 2 * FFH, 1024, (pg8::bf16_t*)H, FFH);
    SEAM(6);
    if (IN(7) && !NOP7) for (int rep_ = 0; rep_ < REP7; ++rep_) GEMM_RUN(EpiResBf16, H, W0D, 1024, FFH, (const pg8::bf16_t*)XB, Y, 1024, ALPHA);
    SEAM(7);
    if (IN(8) && !NOP8) for (int rep_ = 0; rep_ < REP8; ++rep_) ln_phase(Y, args.in[14], args.in[15], nullptr, XB, bid, G, wave, lane);
    SEAM(8);
    if (IN(9) && !NOP9) GEMM_RUN(EpiQKV1, XB, W1IN, L1QKV, 1024, (pg8::bf16_t*)QKV, (pg8::bf16_t*)(QKV + (size_t)M * 1024), (pg8::bf16_t*)(QKV + (size_t)M * 2048), (const float*)tabR);
    SEAM(9);
    if (IN(11) && !NOP11) sweep_pass<false>((char*)lds, QKV, OI, (float*)ws, args.in[17], args.in[18], vcu, G);
    SEAM(11);
    if (IN(12) && !NOP12) sweep_pass<true>((char*)lds, QKV, OI, (float*)ws, args.in[17], args.in[18], vcu, G);
    SEAM(12);
#ifdef PROBE_LIST
    if (lo >= 20) {
        if (lo == 25) qk_norm_rope(PROJ0, args.in[2], args.in[3], tabA, gtid, gthreads);
        if (lo == 26) conv_phase((char*)lds, PROJ0, args.in[4], args.in[5], args.in[6], args.in[7], AC, bid, G);
        if (lo == 20) sweep_pass<true, 1>((char*)lds, QKV, OI, (float*)ws, args.in[17], args.in[18], vcu, G);
        if (lo == 21) sweep_pass<true, 2>((char*)lds, QKV, OI, (float*)ws, args.in[17], args.in[18], vcu, G);
        if (lo == 22) sweep_pass<true, 4>((char*)lds, QKV, OI, (float*)ws, args.in[17], args.in[18], vcu, G);
        if (lo == 23) sweep_pass<true, 8>((char*)lds, QKV, OI, (float*)ws, args.in[17], args.in[18], vcu, G);
        if (lo == 24) sweep_pass<true, 3>((char*)lds, QKV, OI, (float*)ws, args.in[17], args.in[18], vcu, G);
    }
#endif
    if (IN(13) && !NOP13) intra_phase((char*)lds, QKV, OI, args.in[17], args.in[18], args.in[19], vcu, G);
    SEAM(13);
    if (IN(14) && !NOP14) for (int rep_ = 0; rep_ < REP14; ++rep_) GEMM_RUN(EpiGateMul, XB, W1IN + (size_t)4096 * 1024, RVW, 1024, (pg8::bf16_t*)OI, RVW);
    SEAM(14);
    if (IN(15) && !NOP15) for (int rep_ = 0; rep_ < REP15; ++rep_) GEMM_RUN(EpiResBf16, OI, W1OUT, 1024, RVW, (const pg8::bf16_t*)XB, Y1, 1024, ALPHA);
    SEAM(15);
    if (IN(16) && !NOP16) for (int rep_ = 0; rep_ < REP16; ++rep_) ln_phase(Y1, args.in[21], args.in[22], nullptr, XB, bid, G, wave, lane);
    SEAM(16);
    if (IN(17) && !NOP17) for (int rep_ = 0; rep_ < REP17; ++rep_) GEMM_RUN(EpiGateUp, XB, W1GU, 2 * FFH, 1024, (pg8::bf16_t*)H, FFH);
    SEAM(17);
    if (IN(18) && !NOP18) for (int rep_ = 0; rep_ < REP18; ++rep_) GEMM_RUN(EpiResBf16, H, W1D, 1024, FFH, (const pg8::bf16_t*)XB, Y, 1024, ALPHA);
    SEAM(18);
    if (IN(19) && !NOP19) for (int rep_ = 0; rep_ < REP19; ++rep_) ln_phase(Y, args.in[26], args.in[27], out, nullptr, bid, G, wave, lane);
#undef IN
#undef SEAM
#undef GEMM_RUN
}

#ifndef MK_ONE_LAUNCH
#define MK_ONE_LAUNCH 1
#endif
extern "C" void kernel_launch(void* const* d_in, const int* in_sizes, int n_in, void* d_out, int out_size, void* d_ws, size_t ws_size, hipStream_t stream) {
    static int grid = 0;
    if (grid == 0) {
        if (n_in != 28 || out_size != M * DMODEL || ws_size < WS_NEED) { fprintf(stderr, "kernel_launch: unexpected sizes: n_in %d out %d ws %zu\n", n_in, out_size, ws_size); grid = -1; return; }
        int dev = 0, cus = 0, per_cu = 0;
        hipGetDevice(&dev); hipDeviceGetAttribute(&cus, hipDeviceAttributeMultiprocessorCount, dev);
        hipFuncSetAttribute((const void*)mk_fwd, hipFuncAttributeMaxDynamicSharedMemorySize, LDS_BYTES);
        hipOccupancyMaxActiveBlocksPerMultiprocessor(&per_cu, (const void*)mk_fwd, NTHR, LDS_BYTES);
        if (per_cu < 1) { fprintf(stderr, "kernel_launch: occupancy query says %d blocks per CU\n", per_cu); per_cu = 1; }
        (void)hipGetLastError();
        grid = cus * per_cu;
    }
    if (grid < 0) return;
    Args a{};
    for (int i = 0; i < 28; ++i) a.in[i] = (const float*)d_in[i];
    a.out = (float*)d_out; a.ws = (unsigned char*)d_ws;
#if MK_ONE_LAUNCH
    a.ph_lo = 0; a.ph_hi = 20;
    (void)hipMemsetAsync((char*)d_ws + WS_BAR, 0, 16384, stream);
    void* kargs[] = {&a};
    hipError_t e = hipLaunchCooperativeKernel((const void*)mk_fwd, dim3(grid), dim3(NTHR), kargs, LDS_BYTES, stream);
    if (e != hipSuccess) fprintf(stderr, "cooperative launch failed: %s (grid %d)\n", hipGetErrorString(e), grid);
#ifdef PROBE_LIST
    { const int plist[] = PROBE_LIST; for (int p : plist) { a.ph_lo = p; a.ph_hi = p + 1; hipLaunchKernelGGL(mk_fwd, dim3(grid), dim3(NTHR), LDS_BYTES, stream, a); } }
#endif
#else
    for (int p = 0; p < 20; ++p) { a.ph_lo = p; a.ph_hi = p + 1; hipLaunchKernelGGL(mk_fwd, dim3(grid), dim3(NTHR), LDS_BYTES, stream, a); }
#endif
}
```
